# Optimizing an MI355X kernel written in HIP

```python
import math
import jax, jax.numpy as jnp
from jax import lax
import numpy as np

D_MODEL = 1024
BATCH = 4
SEQ = 4096
DEPTH = 2

N_A_LAYERS = max(1, DEPTH // 2)
N_B_LAYERS = DEPTH - N_A_LAYERS

A_HEADS = D_MODEL // 128
A_HEAD_DIM = 64
A_V_DIM = 2 * A_HEAD_DIM
A_QK_WIDTH = A_HEADS * 2 * A_HEAD_DIM
A_V_WIDTH = A_HEADS * A_V_DIM
LAMBDA_INIT_BASE = 0.8
LAMBDA_INIT_AMP = 0.6
LAMBDA_INIT_RATE = 0.3

ROPE_THETA = 500000.0
ROT_DIM = A_HEAD_DIM // 4

B_HEADS = D_MODEL // 64
B_HEAD_DIM = 64
B_WIDTH = B_HEADS * B_HEAD_DIM

D_FF = -(-8 * D_MODEL // (3 * 256)) * 256

Q_BLOCK = 128
EPS = 1e-6

kernel_name = 'yoco_diff_stickbreaking_trunk'


def rms_norm(x, g):
    x32 = x.astype(jnp.float32)
    y = x32 * lax.rsqrt(jnp.mean(x32 * x32, axis=-1, keepdims=True) + EPS)
    return (y * g.astype(jnp.float32)).astype(x.dtype)


def rope_tables(seq):
    pos = jnp.arange(seq, dtype=jnp.float32)
    inv_freq = ROPE_THETA ** (-jnp.arange(0, ROT_DIM, 2, dtype=jnp.float32) / ROT_DIM)
    ang = pos[:, None] * inv_freq[None, :]
    return jnp.cos(ang), jnp.sin(ang)


def apply_partial_rope(t, cos, sin):
    half = ROT_DIM // 2
    t1 = t[..., :half].astype(jnp.float32)
    t2 = t[..., half:ROT_DIM].astype(jnp.float32)
    r1 = t1 * cos - t2 * sin
    r2 = t2 * cos + t1 * sin
    return jnp.concatenate([r1.astype(t.dtype), r2.astype(t.dtype), t[..., ROT_DIM:]], axis=-1)


def to_blocks(t):
    b, h, s, d = t.shape
    return t.reshape(b, h, s // Q_BLOCK, Q_BLOCK, d).transpose(2, 0, 1, 3, 4)


def from_blocks(o):
    nb, b, h, qb, d = o.shape
    return o.transpose(1, 0, 3, 2, 4).reshape(b, nb * qb, h, d)


def diff_attention(h, w_qkv, w_o, lq1, lk1, lq2, lk2, subln_g, lambda_init, cos, sin):
    b, s, _ = h.shape
    qkv = h @ w_qkv
    q, k, v = jnp.split(qkv, [A_QK_WIDTH, 2 * A_QK_WIDTH], axis=-1)
    q = q.reshape(b, s, 2 * A_HEADS, A_HEAD_DIM).transpose(0, 2, 1, 3)
    k = k.reshape(b, s, 2 * A_HEADS, A_HEAD_DIM).transpose(0, 2, 1, 3)
    v = v.reshape(b, s, A_HEADS, A_V_DIM).transpose(0, 2, 1, 3)
    q = apply_partial_rope(q, cos, sin)
    k = apply_partial_rope(k, cos, sin)
    f32 = jnp.float32
    lam = (jnp.exp(jnp.sum(lq1.astype(f32) * lk1.astype(f32)))
           - jnp.exp(jnp.sum(lq2.astype(f32) * lk2.astype(f32))) + lambda_init)
    scale = A_HEAD_DIM ** -0.5
    kpos = jnp.arange(s)
    n_blocks = s // Q_BLOCK

    def block(args):
        qb, start = args
        sc = jnp.einsum('bhqd,bhkd->bhqk', qb, k).astype(f32) * scale
        qpos = start + jnp.arange(Q_BLOCK)
        mask = kpos[None, :] <= qpos[:, None]
        p = jax.nn.softmax(jnp.where(mask, sc, -jnp.inf), axis=-1)
        p = p.reshape(b, A_HEADS, 2, Q_BLOCK, s)
        a = p[:, :, 0] - lam * p[:, :, 1]
        return jnp.einsum('bhqk,bhkd->bhqd', a.astype(v.dtype), v)

    o = lax.map(block, (to_blocks(q), jnp.arange(n_blocks) * Q_BLOCK))
    o = from_blocks(o)
    o = rms_norm(o, subln_g) * (1.0 - lambda_init)
    return o.reshape(b, s, A_V_WIDTH).astype(h.dtype) @ w_o


def stick_breaking_attention(h, w_q, w_o, k, v):
    b, s, _ = h.shape
    q = (h @ w_q).reshape(b, s, B_HEADS, B_HEAD_DIM).transpose(0, 2, 1, 3)
    f32 = jnp.float32
    scale = B_HEAD_DIM ** -0.5
    kpos = jnp.arange(s)
    n_blocks = s // Q_BLOCK

    def block(args):
        qb, start = args
        z = jnp.einsum('bhqd,bhkd->bhqk', qb, k).astype(f32) * scale
        qpos = start + jnp.arange(Q_BLOCK)
        mask = kpos[None, :] < qpos[:, None]
        log_beta = jax.nn.log_sigmoid(z)
        log_1m = jnp.where(mask, jax.nn.log_sigmoid(-z), 0.0)
        between = lax.cumsum(log_1m, axis=3, reverse=True) - log_1m
        a = jnp.where(mask, jnp.exp(log_beta + between), 0.0)
        return jnp.einsum('bhqk,bhkd->bhqd', a.astype(v.dtype), v)

    o = lax.map(block, (to_blocks(q), jnp.arange(n_blocks) * Q_BLOCK))
    o = from_blocks(o).reshape(b, s, B_WIDTH)
    return o @ w_o


def swiglu(h, w_gate_up, w_down):
    gate, up = jnp.split(h @ w_gate_up, 2, axis=-1)
    return (jax.nn.silu(gate) * up) @ w_down


def setup_inputs(seed: int = 0) -> dict:
    key = jax.random.key(seed)
    ks = jax.random.split(key, 24)
    f32 = jnp.float32

    def w(k, shape, fan_in):
        return jax.random.normal(k, shape, f32) * (fan_in ** -0.5)

    def gain(k, shape):
        return 1.0 + 0.02 * jax.random.normal(k, shape, f32)

    return {
        'x': jax.random.normal(ks[0], (BATCH, SEQ, D_MODEL), f32),
        'a_w_qkv': w(ks[1], (N_A_LAYERS, D_MODEL, 2 * A_QK_WIDTH + A_V_WIDTH), D_MODEL),
        'a_w_o': w(ks[2], (N_A_LAYERS, A_V_WIDTH, D_MODEL), A_V_WIDTH),
        'a_lambda_q1': 0.1 * jax.random.normal(ks[3], (N_A_LAYERS, A_HEAD_DIM), f32),
        'a_lambda_k1': 0.1 * jax.random.normal(ks[4], (N_A_LAYERS, A_HEAD_DIM), f32),
        'a_lambda_q2': 0.1 * jax.random.normal(ks[5], (N_A_LAYERS, A_HEAD_DIM), f32),
        'a_lambda_k2': 0.1 * jax.random.normal(ks[6], (N_A_LAYERS, A_HEAD_DIM), f32),
        'a_subln_g': gain(ks[7], (N_A_LAYERS, A_V_DIM)),
        'kv_norm_g': gain(ks[8], (D_MODEL,)),
        'kv_w': w(ks[9], (D_MODEL, 2 * B_WIDTH), D_MODEL),
        'b_w_q': w(ks[10], (N_B_LAYERS, D_MODEL, B_WIDTH), D_MODEL),
        'b_w_o': w(ks[11], (N_B_LAYERS, B_WIDTH, D_MODEL), B_WIDTH),
        'mix_pre_g': gain(ks[12], (DEPTH, D_MODEL)),
        'mix_post_g': gain(ks[13], (DEPTH, D_MODEL)),
        'ffn_pre_g': gain(ks[14], (DEPTH, D_MODEL)),
        'ffn_post_g': gain(ks[15], (DEPTH, D_MODEL)),
        'ffn_w_gate_up': w(ks[16], (DEPTH, D_MODEL, 2 * D_FF), D_MODEL),
        'ffn_w_down': w(ks[17], (DEPTH, D_FF, D_MODEL), D_FF),
    }


def reference(x, a_w_qkv, a_w_o, a_lambda_q1, a_lambda_k1, a_lambda_q2, a_lambda_k2,
              a_subln_g, kv_norm_g, kv_w, b_w_q, b_w_o, mix_pre_g, mix_post_g,
              ffn_pre_g, ffn_post_g, ffn_w_gate_up, ffn_w_down):
    b, s, _ = x.shape
    cos, sin = rope_tables(s)
    shared_k = None
    shared_v = None
    for layer in range(DEPTH):
        h = rms_norm(x, mix_pre_g[layer])
        if layer < N_A_LAYERS:
            lambda_init = LAMBDA_INIT_BASE - LAMBDA_INIT_AMP * math.exp(-LAMBDA_INIT_RATE * layer)
            m = diff_attention(h, a_w_qkv[layer], a_w_o[layer],
                               a_lambda_q1[layer], a_lambda_k1[layer],
                               a_lambda_q2[layer], a_lambda_k2[layer],
                               a_subln_g[layer], lambda_init, cos, sin)
        else:
            if shared_k is None:
                kv = rms_norm(x, kv_norm_g) @ kv_w
                kk, vv = jnp.split(kv, 2, axis=-1)
                shared_k = kk.reshape(b, s, B_HEADS, B_HEAD_DIM).transpose(0, 2, 1, 3)
                shared_v = vv.reshape(b, s, B_HEADS, B_HEAD_DIM).transpose(0, 2, 1, 3)
            j = layer - N_A_LAYERS
            m = stick_breaking_attention(h, b_w_q[j], b_w_o[j], shared_k, shared_v)
        x = x + rms_norm(m, mix_post_g[layer])
        f = swiglu(rms_norm(x, ffn_pre_g[layer]), ffn_w_gate_up[layer], ffn_w_down[layer])
        x = x + rms_norm(f, ffn_post_g[layer])
    return x
```

```cpp
#include <hip/hip_runtime.h>
#include <hip/hip_cooperative_groups.h>
#include <cstdio>
#include <cstdint>
#include <cmath>
namespace cg = cooperative_groups;
namespace pg8 {
#define PG8_LAS __attribute__((address_space(3)))
typedef unsigned short bf16_t;
typedef short bf16x8 __attribute__((ext_vector_type(8)));
typedef float f32x4 __attribute__((ext_vector_type(4)));
typedef unsigned u32x4 __attribute__((ext_vector_type(4)));
constexpr int BM = 256, BK = 64, HALF = 128, HTB = HALF * BK * 2  , STAGE_BYTES = 8 * HTB, NXCD = 8, WGM = 8;

__host__ __device__ __forceinline__ int lds_byte(int r, int c) { const int st = (r >> 4) * 2 + (c >> 5), rr = r & 15, cc = c & 31, ob = rr * 64 + cc * 2; return st * 1024 + (ob ^ (((ob >> 9) & 1) << 5)); }
__host__ __device__ __forceinline__ void stage_rc(int b, int& R, int& C) { const int st = b / 1024, sb = b % 1024, swz = sb ^ (((sb >> 9) & 1) << 5); R = (st >> 1) * 16 + swz / 64; C = (st & 1) * 32 + (swz % 64) / 2; }
__host__ __device__ __forceinline__ int perm32(int rho) { const int n = rho >> 4, i = rho & 15; return 8 * (i >> 2) + 4 * n + (i & 3); }

struct Unit { int pm, pn; };
struct Gemm { const bf16_t* A; const bf16_t* Bt; int M, N, K, lda, ldb; };

struct StaticOrder {
    int nM, nN, nwg, G, c;
    __host__ __device__ void init(int M, int N, int G_, int c_) { nM = M / BM; nN = N / BM; nwg = nM * nN; G = G_; c = c_; }
    __host__ __device__ bool next(int i, Unit& u) const {
        const long L = (long)i * G + c; if (L >= nwg) return false;
        int wgid = (int)L; { const int q = nwg / NXCD, r = nwg % NXCD, xcd = wgid % NXCD, off = wgid / NXCD; wgid = (xcd < r ? xcd * (q + 1) : r * (q + 1) + (xcd - r) * q) + off; }
        const int nig = WGM * nN, gid = wgid / nig, fm = gid * WGM, gsz = (nM - fm) < WGM ? (nM - fm) : WGM;
        u.pm = fm + ((wgid % nig) % gsz); u.pn = (wgid % nig) / gsz; return true;
    }
    __device__ __forceinline__ void a_ready(const Unit&) const {}
    __device__ __forceinline__ void done(const Unit&) const {}
};
__device__ __forceinline__ unsigned cvt_pk_bf16(float lo, float hi) { unsigned r; asm volatile("v_cvt_pk_bf16_f32 %0, %1, %2" : "=v"(r) : "v"(lo), "v"(hi)); return r; }
typedef float f32x2 __attribute__((ext_vector_type(2)));
template <bool ROPE> struct EpiBf16 {
    static constexpr bool PERM = true, AFTER_DRAIN = false;
    bf16_t* O; int ldc; const float* rope;
    __device__ __forceinline__ void operator()(const f32x4 (&acc)[2][2][4][2], const Unit& u, int wr, int wc, int fr, int fq) const {
        const int row0 = u.pm * BM + wr * 64 + fr; const int col0 = u.pn * BM + wc * 32 + 8 * fq;
        const bool rot = ROPE && ((wc & 1) == 0);
        const float sgn = (fq == 0) ? -1.f : 1.f;
#pragma unroll
        for (int ai = 0; ai < 2; ++ai)
#pragma unroll
            for (int m = 0; m < 4; ++m) { const int row = row0 + ai * HALF + m * 16; bf16_t* rowp = O + (size_t)row * ldc + col0;
                f32x4 c0 = {1.f, 1.f, 1.f, 1.f}, c1 = c0, s0 = {0.f, 0.f, 0.f, 0.f}, s1 = s0;
                if (ROPE) { if (rot && fq < 2) { const float* rp = rope + (size_t)(row & 4095) * 16; c0 = *(const f32x4*)(rp); c1 = *(const f32x4*)(rp + 4); s0 = *(const f32x4*)(rp + 8) * sgn; s1 = *(const f32x4*)(rp + 12) * sgn; } }
#pragma unroll
                for (int bj = 0; bj < 2; ++bj) { f32x4 v0 = acc[ai][bj][m][0], v1 = acc[ai][bj][m][1];
                    if (ROPE) { if (rot) { f32x4 p0, p1;
#pragma unroll
                            for (int e = 0; e < 4; ++e) { p0[e] = __shfl_xor(v0[e], 16); p1[e] = __shfl_xor(v1[e], 16); }
                            v0 = v0 * c0 + p0 * s0; v1 = v1 * c1 + p1 * s1; } }
                    u32x4 w; w.x = cvt_pk_bf16(v0[0], v0[1]); w.y = cvt_pk_bf16(v0[2], v0[3]); w.z = cvt_pk_bf16(v1[0], v1[1]); w.w = cvt_pk_bf16(v1[2], v1[3]);
                    *(u32x4*)(rowp + bj * HALF) = w; } }
    }
};
struct EpiSwiglu {
    static constexpr bool PERM = true, AFTER_DRAIN = false;
    bf16_t* O; int ldc;
    __device__ __forceinline__ static float sw(float g, float up) { return g * up * __builtin_amdgcn_rcpf(1.f + __builtin_amdgcn_exp2f(-1.4426950408889634f * g)); }
    __device__ __forceinline__ void operator()(const f32x4 (&acc)[2][2][4][2], const Unit& u, int wr, int wc, int fr, int fq) const {
        const int row0 = u.pm * BM + wr * 64 + fr; const int col0 = u.pn * HALF + wc * 32 + 8 * fq;
#pragma unroll
        for (int ai = 0; ai < 2; ++ai)
#pragma unroll
            for (int m = 0; m < 4; ++m) { bf16_t* rowp = O + (size_t)(row0 + ai * HALF + m * 16) * ldc + col0;
                const f32x4 g0 = acc[ai][0][m][0], g1 = acc[ai][0][m][1], u0 = acc[ai][1][m][0], u1 = acc[ai][1][m][1];
                u32x4 w; w.x = cvt_pk_bf16(sw(g0[0], u0[0]), sw(g0[1], u0[1])); w.y = cvt_pk_bf16(sw(g0[2], u0[2]), sw(g0[3], u0[3]));
                w.z = cvt_pk_bf16(sw(g1[0], u1[0]), sw(g1[1], u1[1])); w.w = cvt_pk_bf16(sw(g1[2], u1[2]), sw(g1[3], u1[3]));
                *(u32x4*)rowp = w; }
    }
};
struct EpiF32 {
    static constexpr bool PERM = false, AFTER_DRAIN = false;
    float* O; int ldc;
    __device__ __forceinline__ void operator()(const f32x4 (&acc)[2][2][4][2], const Unit& u, int wr, int wc, int fr, int fq) const {
        const int row0 = u.pm * BM + wr * 64 + fr; const int col0 = u.pn * BM + wc * 32 + 4 * fq;
#pragma unroll
        for (int ai = 0; ai < 2; ++ai)
#pragma unroll
            for (int m = 0; m < 4; ++m) { float* rowp = O + (size_t)(row0 + ai * HALF + m * 16) * ldc + col0;
#pragma unroll
                for (int bj = 0; bj < 2; ++bj)
#pragma unroll
                    for (int n = 0; n < 2; ++n) *(f32x4*)(rowp + bj * HALF + n * 16) = acc[ai][bj][m][n]; }
    }
};
template <class Epi, class Sched, bool ALIGN_EPI = false, bool SP2 = false>
__device__ __forceinline__ void gemm_phase(PG8_LAS unsigned char* lds, const Gemm g, const Sched& S, const Epi& E) {
    int tid_ = threadIdx.x; asm volatile("" : "+v"(tid_));
    const int tid = tid_, wid = __builtin_amdgcn_readfirstlane(tid >> 6), lane = tid & 63, wr = wid >> 2, wc = wid & 3, fr = lane & 15, fq = lane >> 4;
    const int K = g.K, nt = K / BK;
    unsigned voffA[2], voffB[2];
#pragma unroll
    for (int i = 0; i < 2; ++i) { int R, C; stage_rc(tid * 16 + i * 8192, R, C); const int Rb = Epi::PERM ? ((R & ~31) + perm32(R & 31)) : R;
        voffA[i] = (unsigned)(R * g.lda + C) * 2u; voffB[i] = (unsigned)(Rb * g.ldb + C) * 2u; }
    const size_t kstep = (size_t)(BK * 2);
    const size_t hstepA = (size_t)HALF * g.lda * 2, hstepB = (size_t)HALF * g.ldb * 2;
    const size_t tstepA = 2 * hstepA, tstepB = 2 * hstepB;
    const unsigned ldsw = (unsigned)wid * 1024u;
    const int aoff = lds_byte(wr * 64 + fr, fq * 8), boff = lds_byte(wc * 32 + fr, fq * 8);
#define PG8_SA(b, h) (((b) * 2 + (h)) * HTB)
#define PG8_SB(b, h) ((4 + (b) * 2 + (h)) * HTB)
#define PG8_STAGE(bufoff, gbase, voff) do { _Pragma("unroll") for (int _i = 0; _i < 2; ++_i) \
        __builtin_amdgcn_global_load_lds((const unsigned*)((const char*)(gbase) + (voff)[_i]), (PG8_LAS unsigned*)(lds + (bufoff) + ldsw + _i * 8192), 16, 0, 0); } while (0)
#define PG8_LDA(dst, b, h) do { _Pragma("unroll") for (int m = 0; m < 4; ++m) _Pragma("unroll") for (int k = 0; k < 2; ++k) dst[m][k] = *(const PG8_LAS bf16x8*)(lds + PG8_SA(b, h) + aoff + m * 2048 + k * 1024); } while (0)
#define PG8_LDB(dst, b, h) do { _Pragma("unroll") for (int n = 0; n < 2; ++n) _Pragma("unroll") for (int k = 0; k < 2; ++k) dst[n][k] = *(const PG8_LAS bf16x8*)(lds + PG8_SB(b, h) + boff + n * 2048 + k * 1024); } while (0)
#define PG8_MMA(ai, bj, At, Bt) do { __builtin_amdgcn_s_setprio(1); _Pragma("unroll") for (int m = 0; m < 4; ++m) _Pragma("unroll") for (int n = 0; n < 2; ++n) _Pragma("unroll") for (int k = 0; k < 2; ++k) \
        acc[ai][bj][m][n] = __builtin_amdgcn_mfma_f32_16x16x32_bf16(Bt[n][k], At[m][k], acc[ai][bj][m][n], 0, 0, 0); __builtin_amdgcn_s_setprio(0); } while (0)
#define PG8_WAIT_V(n) asm volatile("s_waitcnt vmcnt(" #n ")" ::: "memory")
#define PG8_WAIT_L(n) asm volatile("s_waitcnt lgkmcnt(" #n ")" ::: "memory")
#define PG8_BAR __builtin_amdgcn_s_barrier()
#define PG8_SCHED __builtin_amdgcn_sched_barrier(0)
    Unit cur, nxt; int ui = 0;
    if (!S.next(0, cur)) return;
    f32x4 acc[2][2][4][2];
#pragma unroll
    for (int a = 0; a < 2; ++a)
#pragma unroll
        for (int b = 0; b < 2; ++b)
#pragma unroll
            for (int m = 0; m < 4; ++m)
#pragma unroll
                for (int n = 0; n < 2; ++n) acc[a][b][m][n] = (f32x4){0.f, 0.f, 0.f, 0.f};
    bf16x8 At[4][2], B0[2][2], B1[2][2];
    const char* cA = (const char*)g.A + (size_t)cur.pm * tstepA; const char* cB = (const char*)g.Bt + (size_t)cur.pn * tstepB;
    S.a_ready(cur);
    if constexpr (SP2) {
        PG8_STAGE(PG8_SB(0, 0), cB, voffB); PG8_STAGE(PG8_SB(0, 1), cB + hstepB, voffB); PG8_STAGE(PG8_SA(0, 0), cA, voffA); PG8_STAGE(PG8_SA(0, 1), cA + hstepA, voffA);
        if (wr == 1) PG8_BAR;
        PG8_WAIT_V(2); PG8_BAR;
        PG8_STAGE(PG8_SB(1, 0), cB + kstep, voffB); PG8_STAGE(PG8_SA(1, 0), cA + kstep, voffA); PG8_STAGE(PG8_SB(1, 1), cB + hstepB + kstep, voffB);
        PG8_WAIT_V(6); PG8_BAR;
    } else {
        PG8_STAGE(PG8_SB(0, 0), cB, voffB); PG8_STAGE(PG8_SA(0, 0), cA, voffA); PG8_STAGE(PG8_SB(0, 1), cB + hstepB, voffB); PG8_STAGE(PG8_SA(0, 1), cA + hstepA, voffA);
        if (wr == 1) PG8_BAR;
        PG8_WAIT_V(4); PG8_BAR;
        PG8_STAGE(PG8_SB(1, 0), cB + kstep, voffB); PG8_STAGE(PG8_SA(1, 0), cA + kstep, voffA); PG8_STAGE(PG8_SB(1, 1), cB + hstepB + kstep, voffB);
        PG8_WAIT_V(6); PG8_BAR;
    }
    for (;;) {
        const bool has_next = S.next(ui + 1, nxt);
        const char* nA = has_next ? (const char*)g.A + (size_t)nxt.pm * tstepA : cA; const char* nB = has_next ? (const char*)g.Bt + (size_t)nxt.pn * tstepB : cB;
        for (int t = 0; t < nt; t += 2) {
            const bool last = (t == nt - 2);
            const char* a1 = cA + (size_t)(t + 1) * kstep;
            const char* a2 = last ? nA : cA + (size_t)(t + 2) * kstep; const char* b2 = last ? nB : cB + (size_t)(t + 2) * kstep;
            const char* a3 = a2 + kstep; const char* b3 = b2 + kstep;
            if (last && has_next) S.a_ready(nxt);
            if constexpr (SP2) {
            PG8_LDB(B0, 0, 0); PG8_LDB(B1, 0, 1); PG8_SCHED; PG8_LDA(At, 0, 0); PG8_STAGE(PG8_SA(1, 1), a1 + hstepA, voffA);
            PG8_WAIT_V(8); PG8_WAIT_L(0); PG8_BAR; PG8_MMA(0, 0, At, B0); PG8_MMA(0, 1, At, B1); PG8_BAR; PG8_SCHED;
            PG8_LDA(At, 0, 1); PG8_STAGE(PG8_SB(0, 0), b2, voffB); PG8_STAGE(PG8_SB(0, 1), b2 + hstepB, voffB); PG8_STAGE(PG8_SA(0, 0), a2, voffA);
            PG8_WAIT_V(8); PG8_WAIT_L(0); PG8_BAR; PG8_MMA(1, 0, At, B0); PG8_MMA(1, 1, At, B1); PG8_BAR; PG8_SCHED;
            PG8_LDB(B0, 1, 0); PG8_LDB(B1, 1, 1); PG8_SCHED; PG8_LDA(At, 1, 0); PG8_STAGE(PG8_SA(0, 1), a2 + hstepA, voffA);
            PG8_WAIT_V(8); PG8_WAIT_L(0); PG8_BAR; PG8_MMA(0, 0, At, B0); PG8_MMA(0, 1, At, B1); PG8_BAR; PG8_SCHED;
            PG8_LDA(At, 1, 1); PG8_STAGE(PG8_SB(1, 0), b3, voffB); PG8_STAGE(PG8_SB(1, 1), b3 + hstepB, voffB); PG8_STAGE(PG8_SA(1, 0), a3, voffA);
            PG8_WAIT_V(8); PG8_WAIT_L(0); PG8_BAR; PG8_MMA(1, 0, At, B0); PG8_MMA(1, 1, At, B1); PG8_BAR; PG8_SCHED;
            } else {
            PG8_LDB(B0, 0, 0); PG8_SCHED; PG8_LDA(At, 0, 0); PG8_STAGE(PG8_SA(1, 1), a1 + hstepA, voffA);
            PG8_WAIT_L(8); PG8_BAR; PG8_WAIT_L(0); PG8_MMA(0, 0, At, B0); PG8_BAR; PG8_SCHED;
            PG8_LDB(B1, 0, 1); PG8_STAGE(PG8_SB(0, 0), b2, voffB);
            PG8_BAR; PG8_WAIT_L(0); PG8_MMA(0, 1, At, B1); PG8_BAR;
            PG8_LDA(At, 0, 1); PG8_STAGE(PG8_SA(0, 0), a2, voffA);
            PG8_BAR; PG8_WAIT_L(0); PG8_MMA(1, 0, At, B0); PG8_BAR; PG8_SCHED;
            PG8_STAGE(PG8_SB(0, 1), b2 + hstepB, voffB);
            PG8_WAIT_V(6); PG8_BAR; PG8_MMA(1, 1, At, B1); PG8_BAR;
            PG8_LDB(B0, 1, 0); PG8_SCHED; PG8_LDA(At, 1, 0); PG8_STAGE(PG8_SA(0, 1), a2 + hstepA, voffA);
            PG8_WAIT_L(8); PG8_BAR; PG8_WAIT_L(0); PG8_MMA(0, 0, At, B0); PG8_BAR; PG8_SCHED;
            PG8_LDB(B1, 1, 1); PG8_STAGE(PG8_SB(1, 0), b3, voffB);
            PG8_BAR; PG8_WAIT_L(0); PG8_MMA(0, 1, At, B1); PG8_BAR;
            PG8_LDA(At, 1, 1); PG8_STAGE(PG8_SA(1, 0), a3, voffA);
            PG8_BAR; PG8_WAIT_L(0); PG8_MMA(1, 0, At, B0); PG8_BAR; PG8_SCHED;
            PG8_STAGE(PG8_SB(1, 1), b3 + hstepB, voffB);
            PG8_WAIT_V(6); PG8_BAR; PG8_MMA(1, 1, At, B1); PG8_BAR;
            }
        }
        if constexpr (ALIGN_EPI) { if (wr == 0) PG8_BAR; }
        if constexpr (!Epi::AFTER_DRAIN) { E(acc, cur, wr, wc, fr, fq); S.done(cur); }
        if (!has_next) break;
#pragma unroll
        for (int a = 0; a < 2; ++a)
#pragma unroll
            for (int b = 0; b < 2; ++b)
#pragma unroll
                for (int m = 0; m < 4; ++m)
#pragma unroll
                    for (int n = 0; n < 2; ++n) acc[a][b][m][n] = (f32x4){0.f, 0.f, 0.f, 0.f};
        cur = nxt; cA = nA; cB = nB; ++ui;
        if constexpr (ALIGN_EPI) { if (wr == 1) PG8_BAR; }
    }
    PG8_WAIT_V(0);
    if constexpr (!ALIGN_EPI) { if (wr == 0) PG8_BAR; }
    PG8_BAR;
    if constexpr (Epi::AFTER_DRAIN) { E.fused(acc, cur, wr, wc, fr, fq, lds, wid, lane); S.done(cur); }
#undef PG8_SA
#undef PG8_SB
#undef PG8_STAGE
#undef PG8_LDA
#undef PG8_LDB
#undef PG8_MMA
#undef PG8_WAIT_V
#undef PG8_WAIT_L
#undef PG8_BAR
#undef PG8_SCHED
}
}

namespace att {
#define ALAS __attribute__((address_space(3)))
typedef short bf16x8 __attribute__((ext_vector_type(8)));
typedef float f32x16 __attribute__((ext_vector_type(16)));
typedef float f32x4 __attribute__((ext_vector_type(4)));
typedef unsigned u32x4 __attribute__((ext_vector_type(4)));
typedef unsigned short bf16_t;
constexpr int SEQ = 4096, LDQ = 2048, LDV = 16384;
constexpr int KP = 144, VP = 144, KBUF = 64 * KP, VBUF = 128 * VP;
constexpr int OFF_K = 0, OFF_V = 2 * KBUF, OFF_WSF = OFF_V + 2 * VBUF, OFF_OST = OFF_WSF + 8 * 256, LDS_BYTES = OFF_OST + 8 * 8192;
__device__ __forceinline__ unsigned cvtpk(float lo, float hi) { unsigned r; asm("v_cvt_pk_bf16_f32 %0, %1, %2" : "=v"(r) : "v"(lo), "v"(hi)); return r; }
__device__ __forceinline__ float swap_max(float m) { auto rr = __builtin_amdgcn_permlane32_swap(__float_as_uint(m), __float_as_uint(m), false, false); return fmaxf(__uint_as_float(rr[0]), __uint_as_float(rr[1])); }
__device__ __forceinline__ float swap_sum(float m) { auto rr = __builtin_amdgcn_permlane32_swap(__float_as_uint(m), __float_as_uint(m), false, false); return __uint_as_float(rr[0]) + __uint_as_float(rr[1]); }
__device__ __forceinline__ float swap_other(float m, int hi) { auto rr = __builtin_amdgcn_permlane32_swap(__float_as_uint(m), __float_as_uint(m), false, false); return __uint_as_float(hi ? rr[0] : rr[1]); }
#define MFMA32(a, b, c) __builtin_amdgcn_mfma_f32_32x32x16_bf16((a), (b), (c), 0, 0, 0)


__device__ __forceinline__ void diff_unit(ALAS unsigned char* lds, const bf16_t* QK, const bf16_t* VT, bf16_t* O, int b, int hp, int u, float lam, const float* subg, float outscale) {
    int tid_ = threadIdx.x; asm volatile("" : "+v"(tid_));
    const int tid = tid_, lane = tid & 63, r32 = lane & 31, hi = lane >> 5, w = __builtin_amdgcn_readfirstlane(tid >> 6);
    const int q0 = 256 * u, NT = 4 * u + 4, qrel = 32 * w + r32;
    const size_t rowbase = (size_t)b * SEQ;
    ALAS float* wsf = (ALAS float*)(lds + OFF_WSF) + w * 64;
    const int srow = tid >> 3, sch = tid & 7;
    const int kperm = (r32 & ~12) | ((r32 & 4) << 1) | ((r32 & 8) >> 1);
    const unsigned kst = (unsigned)(srow * KP + sch * 16), vst = (unsigned)(srow * VP + sch * 16);
    unsigned svp[4][8];
#pragma unroll 1
    for (int hh = 0; hh < 2; ++hh) {
        const int hq = 2 * hp + hh;
        const bf16_t* Qw = QK + (rowbase + q0 + 32 * w + r32) * LDQ + hq * 64 + hi * 8;
        bf16x8 qr[4];
#pragma unroll
        for (int d0 = 0; d0 < 4; ++d0) qr[d0] = *(const bf16x8*)(Qw + d0 * 16);
        const bf16_t* Kg = QK + (rowbase + srow) * LDQ + 1024 + hq * 64 + sch * 8;
        const bf16_t* Vg = VT + (size_t)(hp * 128 + srow) * LDV + rowbase + sch * 8;
        u32x4 kr = *(const u32x4*)Kg, v0 = *(const u32x4*)Vg, v1 = *(const u32x4*)(Vg + (size_t)64 * LDV);
        *(ALAS u32x4*)(lds + OFF_K + kst) = kr; *(ALAS u32x4*)(lds + OFF_V + vst) = v0; *(ALAS u32x4*)(lds + OFF_V + 64 * VP + vst) = v1;
        __syncthreads();
        float mhat = 0.f, l = 0.f; f32x16 o[4]; f32x16 zero16;
#pragma unroll
        for (int i = 0; i < 4; ++i)
#pragma unroll
            for (int r = 0; r < 16; ++r) o[i][r] = 0.f;
#pragma unroll
        for (int r = 0; r < 16; ++r) zero16[r] = 0.f;
#pragma unroll 1
        for (int t = 0; t < NT; ++t) {
            const int buf = t & 1; const bool more = (t + 1 < NT);
            if (more) { kr = *(const u32x4*)(Kg + (size_t)(t + 1) * 64 * LDQ); v0 = *(const u32x4*)(Vg + (t + 1) * 64); v1 = *(const u32x4*)(Vg + (size_t)64 * LDV + (t + 1) * 64); }
            const int jb = t - (NT - 4);
            if (!(jb >= 0 && 64 * jb > 32 * w + 31)) {
                const ALAS unsigned char* Kl = lds + OFF_K + buf * KBUF + kperm * KP + hi * 16;
                f32x16 p0, p1;
#pragma unroll
                for (int d0 = 0; d0 < 4; ++d0) { const bf16x8 a0 = *(const ALAS bf16x8*)(Kl + d0 * 32), a1 = *(const ALAS bf16x8*)(Kl + 32 * KP + d0 * 32);
                    if (d0 == 0) { p0 = MFMA32(a0, qr[0], zero16); p1 = MFMA32(a1, qr[0], zero16); } else { p0 = MFMA32(a0, qr[d0], p0); p1 = MFMA32(a1, qr[d0], p1); } }
                if (jb >= 0) { const int kb0 = 64 * jb + 8 * hi;
#pragma unroll
                    for (int r = 0; r < 16; ++r) { const int key = kb0 + 16 * (r >> 3) + (r & 7); if (key > qrel) p0[r] = -INFINITY; if (key + 32 > qrel) p1[r] = -INFINITY; } }
                float rm = fmaxf(p0[0], p1[0]);
#pragma unroll
                for (int r = 1; r < 16; ++r) rm = fmaxf(rm, fmaxf(p0[r], p1[r]));
                rm = swap_max(rm);
                if (t == 0) { mhat = rm; }
                else if (__any(rm - mhat > 8.f)) {
                    const float dl = fmaxf(rm - mhat, 0.f); mhat += dl;
                    const float f = __builtin_amdgcn_exp2f(-dl); l *= f; if (hi == 0) wsf[r32] = f;
#pragma unroll
                    for (int g = 0; g < 4; ++g) { const f32x4 f4 = *(const ALAS f32x4*)(wsf + 8 * g + 4 * hi);
#pragma unroll
                        for (int i = 0; i < 4; ++i)
#pragma unroll
                            for (int e = 0; e < 4; ++e) o[i][4 * g + e] *= f4[e]; }
                }
                float ls = 0.f;
#pragma unroll
                for (int r = 0; r < 16; ++r) { p0[r] = __builtin_amdgcn_exp2f(p0[r] - mhat); p1[r] = __builtin_amdgcn_exp2f(p1[r] - mhat); ls += p0[r] + p1[r]; }
                l += ls;
                bf16x8 pa[4];
#pragma unroll
                for (int uu = 0; uu < 2; ++uu) { u32x4 a, c; a.x = cvtpk(p0[8 * uu], p0[8 * uu + 1]); a.y = cvtpk(p0[8 * uu + 2], p0[8 * uu + 3]); a.z = cvtpk(p0[8 * uu + 4], p0[8 * uu + 5]); a.w = cvtpk(p0[8 * uu + 6], p0[8 * uu + 7]);
                    c.x = cvtpk(p1[8 * uu], p1[8 * uu + 1]); c.y = cvtpk(p1[8 * uu + 2], p1[8 * uu + 3]); c.z = cvtpk(p1[8 * uu + 4], p1[8 * uu + 5]); c.w = cvtpk(p1[8 * uu + 6], p1[8 * uu + 7]);
                    pa[uu] = __builtin_bit_cast(bf16x8, a); pa[2 + uu] = __builtin_bit_cast(bf16x8, c); }
                const ALAS unsigned char* Vl = lds + OFF_V + buf * VBUF + r32 * VP + hi * 16;
                bf16x8 vb[2][4];
#pragma unroll
                for (int g = 0; g < 4; ++g) vb[0][g] = *(const ALAS bf16x8*)(Vl + g * 32);
                __builtin_amdgcn_sched_barrier(0);
#pragma unroll
                for (int i = 0; i < 4; ++i) {
                    if (i < 3) {
#pragma unroll
                        for (int g = 0; g < 4; ++g) vb[(i + 1) & 1][g] = *(const ALAS bf16x8*)(Vl + (i + 1) * 32 * VP + g * 32); }
#pragma unroll
                    for (int g = 0; g < 4; ++g) o[i] = MFMA32(pa[g], vb[i & 1][g], o[i]);
                    __builtin_amdgcn_sched_barrier(0);
                }
            }
            if (more) { const int nb = buf ^ 1; *(ALAS u32x4*)(lds + OFF_K + nb * KBUF + kst) = kr; *(ALAS u32x4*)(lds + OFF_V + nb * VBUF + vst) = v0; *(ALAS u32x4*)(lds + OFF_V + nb * VBUF + 64 * VP + vst) = v1; }
            __syncthreads();
        }
        l = swap_sum(l);
        if (hi == 0) wsf[r32] = 1.f / l;
#pragma unroll
        for (int g = 0; g < 4; ++g) { const f32x4 f4 = *(const ALAS f32x4*)(wsf + 8 * g + 4 * hi);
#pragma unroll
            for (int i = 0; i < 4; ++i)
#pragma unroll
                for (int e = 0; e < 4; ++e) o[i][4 * g + e] *= f4[e]; }
        if (hh == 0) {
#pragma unroll
            for (int i = 0; i < 4; ++i)
#pragma unroll
                for (int j = 0; j < 8; ++j) svp[i][j] = cvtpk(o[i][2 * j], o[i][2 * j + 1]);
        } else {
            float gg[4];
#pragma unroll
            for (int i = 0; i < 4; ++i) gg[i] = subg[32 * i + r32] * outscale;
            ALAS bf16_t* stg = (ALAS bf16_t*)(lds + OFF_OST) + w * 4096;
#pragma unroll
            for (int r = 0; r < 16; ++r) {
                float c[4], part = 0.f;
#pragma unroll
                for (int i = 0; i < 4; ++i) { const float s0 = __uint_as_float((r & 1) ? (svp[i][r >> 1] & 0xffff0000u) : (svp[i][r >> 1] << 16)); c[i] = s0 - lam * o[i][r]; part += c[i] * c[i]; }
                part += __shfl_xor(part, 1); part += __shfl_xor(part, 2); part += __shfl_xor(part, 4); part += __shfl_xor(part, 8); part += __shfl_xor(part, 16);
                const float rstd = __builtin_amdgcn_rsqf(part * (1.f / 128.f) + 1e-6f);
                const int row = (r & 3) + 8 * (r >> 2) + 4 * hi;
#pragma unroll
                for (int i = 0; i < 4; ++i) stg[row * 128 + 32 * i + r32] = (bf16_t)(cvtpk(c[i] * rstd * gg[i], 0.f) & 0xffffu);
            }
            const ALAS bf16_t* sp = stg + (lane >> 4) * 128 + (lane & 15) * 8;
            bf16_t* gp = O + (rowbase + q0 + 32 * w + (lane >> 4)) * LDQ + hp * 128 + (lane & 15) * 8;
#pragma unroll 1
            for (int it = 0; it < 8; ++it) { const u32x4 v = *(const ALAS u32x4*)sp; *(u32x4*)gp = v; sp += 4 * 128; gp += 4 * LDQ; }
        }
    }
}

__device__ __forceinline__ void sb_unit(ALAS unsigned char* lds, const bf16_t* QK, const bf16_t* VT, bf16_t* O, int b, int h, int u) {
    int tid_ = threadIdx.x; asm volatile("" : "+v"(tid_));
    const int tid = tid_, lane = tid & 63, r32 = lane & 31, hi = lane >> 5, w = __builtin_amdgcn_readfirstlane(tid >> 6);
    const int q0 = 256 * u, NT = 4 * u + 4, qrel = 32 * w + r32;
    const size_t rowbase = (size_t)b * SEQ;
    const int srow = tid >> 3, sch = tid & 7;
    const int kperm = (r32 & ~12) | ((r32 & 4) << 1) | ((r32 & 8) >> 1);
    const unsigned kst = (unsigned)(srow * KP + sch * 16), vst = (unsigned)(srow * VP + sch * 16);
    const bf16_t* Qw = QK + (rowbase + q0 + 32 * w + r32) * LDQ + h * 64 + hi * 8;
    bf16x8 qr[4];
#pragma unroll
    for (int d0 = 0; d0 < 4; ++d0) qr[d0] = *(const bf16x8*)(Qw + d0 * 16);
    const bf16_t* Kg = QK + (rowbase + srow) * LDQ + 1024 + h * 64 + sch * 8;
    const bf16_t* Vg = VT + (size_t)(h * 64 + srow) * LDV + rowbase + sch * 8;
    u32x4 kr = *(const u32x4*)(Kg + (size_t)(NT - 1) * 64 * LDQ), v0 = *(const u32x4*)(Vg + (NT - 1) * 64);
    *(ALAS u32x4*)(lds + OFF_K + kst) = kr; *(ALAS u32x4*)(lds + OFF_V + vst) = v0;
    __syncthreads();
    float R = 0.f; f32x16 o[2];
#pragma unroll
    for (int i = 0; i < 2; ++i)
#pragma unroll
        for (int r = 0; r < 16; ++r) o[i][r] = 0.f;
    bool wdone = false;
#pragma unroll 1
    for (int t = NT - 1, it = 0; ; --t, ++it) {
        const int buf = it & 1; const bool more = (t > 0);
        if (more) { kr = *(const u32x4*)(Kg + (size_t)(t - 1) * 64 * LDQ); v0 = *(const u32x4*)(Vg + (t - 1) * 64); }
        const int jb = t - (NT - 4);
        if (!wdone && !(jb >= 0 && 64 * jb > 32 * w + 30)) {
            const ALAS unsigned char* Kl = lds + OFF_K + buf * KBUF + kperm * KP + hi * 16;
            f32x16 y0, y1;
#pragma unroll
            for (int r = 0; r < 16; ++r) { y0[r] = 0.f; y1[r] = 0.f; }
#pragma unroll
            for (int d0 = 0; d0 < 4; ++d0) { const bf16x8 a0 = *(const ALAS bf16x8*)(Kl + d0 * 32), a1 = *(const ALAS bf16x8*)(Kl + 32 * KP + d0 * 32);
                y0 = MFMA32(a0, qr[d0], y0); y1 = MFMA32(a1, qr[d0], y1); }
            if (jb >= 0) { const int kb0 = 64 * jb + 8 * hi;
#pragma unroll
                for (int r = 0; r < 16; ++r) { const int key = kb0 + 16 * (r >> 3) + (r & 7); if (key >= qrel) y0[r] = -INFINITY; if (key + 32 >= qrel) y1[r] = -INFINITY; } }
            f32x16 L0, L1;
#pragma unroll
            for (int r = 0; r < 16; ++r) { L0[r] = -(fmaxf(y0[r], 0.f) + __builtin_amdgcn_logf(1.f + __builtin_amdgcn_exp2f(-fabsf(y0[r])))); L1[r] = -(fmaxf(y1[r], 0.f) + __builtin_amdgcn_logf(1.f + __builtin_amdgcn_exp2f(-fabsf(y1[r])))); }
            float G[4], Gp[4];
#pragma unroll
            for (int uu = 0; uu < 2; ++uu) { float a = 0.f, c = 0.f;
#pragma unroll
                for (int j = 0; j < 8; ++j) { a += L0[8 * uu + j]; c += L1[8 * uu + j]; }
                G[uu] = a; G[2 + uu] = c; }
#pragma unroll
            for (int g = 0; g < 4; ++g) Gp[g] = swap_other(G[g], hi);
            float T[4];
#pragma unroll
            for (int g = 0; g < 4; ++g) T[g] = G[g] + Gp[g];
            float base[4]; { float aft = R;
#pragma unroll
                for (int g = 3; g >= 0; --g) { base[g] = aft + (hi == 0 ? Gp[g] : 0.f); aft += T[g]; }
                R = aft; }
#pragma unroll
            for (int uu = 0; uu < 2; ++uu) { float a0 = base[uu], a1 = base[2 + uu];
#pragma unroll
                for (int j = 7; j >= 0; --j) { const int r = 8 * uu + j; const float l0 = L0[r], l1 = L1[r];
                    y0[r] = __builtin_amdgcn_exp2f(y0[r] + l0 + a0); a0 += l0; y1[r] = __builtin_amdgcn_exp2f(y1[r] + l1 + a1); a1 += l1; } }
            bf16x8 pa[4];
#pragma unroll
            for (int uu = 0; uu < 2; ++uu) { u32x4 a, c; a.x = cvtpk(y0[8 * uu], y0[8 * uu + 1]); a.y = cvtpk(y0[8 * uu + 2], y0[8 * uu + 3]); a.z = cvtpk(y0[8 * uu + 4], y0[8 * uu + 5]); a.w = cvtpk(y0[8 * uu + 6], y0[8 * uu + 7]);
                c.x = cvtpk(y1[8 * uu], y1[8 * uu + 1]); c.y = cvtpk(y1[8 * uu + 2], y1[8 * uu + 3]); c.z = cvtpk(y1[8 * uu + 4], y1[8 * uu + 5]); c.w = cvtpk(y1[8 * uu + 6], y1[8 * uu + 7]);
                pa[uu] = __builtin_bit_cast(bf16x8, a); pa[2 + uu] = __builtin_bit_cast(bf16x8, c); }
            const ALAS unsigned char* Vl = lds + OFF_V + buf * VBUF + r32 * VP + hi * 16;
#pragma unroll
            for (int i = 0; i < 2; ++i)
#pragma unroll
                for (int g = 0; g < 4; ++g) { const bf16x8 vb = *(const ALAS bf16x8*)(Vl + i * 32 * VP + g * 32); o[i] = MFMA32(pa[g], vb, o[i]); }
            wdone = __all(R < -150.f);
        }
        if (more) { const int nb = buf ^ 1; *(ALAS u32x4*)(lds + OFF_K + nb * KBUF + kst) = kr; *(ALAS u32x4*)(lds + OFF_V + nb * VBUF + vst) = v0; }
        const int alld = __syncthreads_and(wdone ? 1 : 0);
        if (!more || alld) break;
    }
    ALAS bf16_t* stg = (ALAS bf16_t*)(lds + OFF_OST) + w * 4096;
#pragma unroll
    for (int r = 0; r < 16; ++r) { const int row = (r & 3) + 8 * (r >> 2) + 4 * hi;
#pragma unroll
        for (int i = 0; i < 2; ++i) stg[row * 64 + 32 * i + r32] = (bf16_t)(cvtpk(o[i][r], 0.f) & 0xffffu); }
    const ALAS bf16_t* sp = stg + (lane >> 3) * 64 + (lane & 7) * 8;
    bf16_t* gp = O + (rowbase + q0 + 32 * w + (lane >> 3)) * LDQ + h * 64 + (lane & 7) * 8;
#pragma unroll 1
    for (int it = 0; it < 4; ++it) { const u32x4 v = *(const ALAS u32x4*)sp; *(u32x4*)gp = v; sp += 8 * 64; gp += 8 * LDQ; }
}
#undef MFMA32
}

#define LAS __attribute__((address_space(3)))
typedef unsigned short bf16;
typedef unsigned v4u __attribute__((ext_vector_type(4)));
typedef float f32x4 __attribute__((ext_vector_type(4)));
constexpr int NWAVES = 8;
constexpr int BATCH = 4, SEQ = 4096, D = 1024, M = BATCH * SEQ, FF = 2816;
constexpr float EPS = 1e-6f;
constexpr float C2 = 0.125f * 1.4426950408889634f;
constexpr size_t MiB = 1u << 20;
constexpr size_t WS_ROPE = 1 * MiB;
constexpr size_t WS_WQK0 = 2 * MiB, WS_WV0 = 6 * MiB, WS_WO0 = 8 * MiB, WS_WGU0 = 10 * MiB, WS_WD0 = 21 * MiB;
constexpr size_t WS_WQK1 = 27 * MiB, WS_WV1 = 31 * MiB, WS_WO1 = 33 * MiB, WS_WGU1 = 35 * MiB, WS_WD1 = 46 * MiB;
constexpr size_t WS_XN = 54 * MiB, WS_QK = 86 * MiB, WS_VT = 150 * MiB, WS_H = 86 * MiB, WS_MF = 182 * MiB, WS_END = 246 * MiB;
constexpr int LDS_BYTES = 147456;

__device__ __forceinline__ unsigned f2bf(float f) { unsigned u = __builtin_bit_cast(unsigned, f); return (u + 0x7fffu + ((u >> 16) & 1u)) >> 16; }
__device__ __forceinline__ unsigned pk2(float lo, float hi) { return f2bf(lo) | (f2bf(hi) << 16); }
__device__ __forceinline__ float wave_sum(float v) {
#pragma unroll
    for (int o = 1; o < 64; o <<= 1) v += __shfl_xor(v, o);
    return v;
}
struct Args { const float* in[18]; float* out; unsigned char* ws; };
typedef const __attribute__((address_space(4))) Args* KArgs;
__device__ __forceinline__ KArgs get_args() { auto p = __builtin_amdgcn_kernarg_segment_ptr(); asm volatile("" : "+s"(p)); return (KArgs)p; }

__device__ __forceinline__ void tr_item(const float* W, int ldw, int scol0, int k0, const float* g, float scale, bf16* WT, int K, int drow0, LAS float* scr, int lane) {
#pragma unroll 8
    for (int i = 0; i < 32; ++i) { const int kk = 2 * i + (lane >> 5); const float gg = g ? g[k0 + kk] * scale : scale; scr[kk * 33 + (lane & 31)] = W[(size_t)(k0 + kk) * ldw + scol0 + (lane & 31)] * gg; }
    asm volatile("s_waitcnt lgkmcnt(0)" ::: "memory");
    const int c = lane & 7;
#pragma unroll
    for (int j = 0; j < 4; ++j) { const int n = (lane >> 3) + 8 * j; const LAS float* s = scr + (8 * c) * 33 + n;
        v4u o; o.x = pk2(s[0 * 33], s[1 * 33]); o.y = pk2(s[2 * 33], s[3 * 33]); o.z = pk2(s[4 * 33], s[5 * 33]); o.w = pk2(s[6 * 33], s[7 * 33]);
        *(v4u*)(WT + (size_t)(drow0 + n) * K + k0 + 8 * c) = o; }
    asm volatile("s_waitcnt lgkmcnt(0)" ::: "memory");
}
struct Seg { const float* W; const float* g; bf16* dst; int ldw, K, nout, mode, scol; float scale; };
__device__ __forceinline__ Seg make_seg(KArgs ka, int s) {
    unsigned char* ws = ka->ws; Seg r;
    const float* gpre0 = ka->in[12]; const float* gpre1 = ka->in[12] + D; const float* gf0 = ka->in[14]; const float* gf1 = ka->in[14] + D;
    switch (s) {
    case 0:  r = Seg{ka->in[1], gpre0, (bf16*)(ws + WS_WQK0), 3072, D, 1024, 0, 0, C2}; break;
    case 1:  r = Seg{ka->in[1], gpre0, (bf16*)(ws + WS_WQK0) + (size_t)1024 * D, 3072, D, 1024, 0, 1024, 1.f}; break;
    case 2:  r = Seg{ka->in[1], gpre0, (bf16*)(ws + WS_WV0), 3072, D, 1024, 0, 2048, 1.f}; break;
    case 3:  r = Seg{ka->in[2], nullptr, (bf16*)(ws + WS_WO0), 1024, D, 1024, 0, 0, 1.f}; break;
    case 4:  r = Seg{ka->in[16], gf0, (bf16*)(ws + WS_WGU0), 2 * FF, D, 2 * FF, 1, 0, 1.f}; break;
    case 5:  r = Seg{ka->in[17], nullptr, (bf16*)(ws + WS_WD0), 1024, FF, 1024, 0, 0, 1.f}; break;
    case 6:  r = Seg{ka->in[10], gpre1, (bf16*)(ws + WS_WQK1), 1024, D, 1024, 0, 0, C2}; break;
    case 7:  r = Seg{ka->in[9], ka->in[8], (bf16*)(ws + WS_WQK1) + (size_t)1024 * D, 2048, D, 1024, 0, 0, 1.f}; break;
    case 8:  r = Seg{ka->in[9], ka->in[8], (bf16*)(ws + WS_WV1), 2048, D, 1024, 0, 1024, 1.f}; break;
    case 9:  r = Seg{ka->in[11], nullptr, (bf16*)(ws + WS_WO1), 1024, D, 1024, 0, 0, 1.f}; break;
    case 10: r = Seg{ka->in[16] + (size_t)D * 2 * FF, gf1, (bf16*)(ws + WS_WGU1), 2 * FF, D, 2 * FF, 1, 0, 1.f}; break;
    default: r = Seg{ka->in[17] + (size_t)FF * D, nullptr, (bf16*)(ws + WS_WD1), 1024, FF, 1024, 0, 0, 1.f}; break;
    }
    return r;
}
constexpr int NSEG = 12;

template <int MODE  >
__device__ __forceinline__ void row_phase(const float* xin, const float* mf, const float* g, float* out, bf16* XN, int gw, int NGW, int lane_) {
    int lane = lane_; asm volatile("" : "+v"(lane));
    for (int m = gw; m < M; m += NGW) {
        const f32x4* xr = (const f32x4*)(xin + (size_t)m * D) + lane;
        f32x4 x[4];
#pragma unroll
        for (int j = 0; j < 4; ++j) x[j] = xr[64 * j];
        if (MODE != 0) {
            const f32x4* mr = (const f32x4*)(mf + (size_t)m * D) + lane; const f32x4* gr = (const f32x4*)g + lane;
            f32x4 v[4]; float s = 0.f;
#pragma unroll
            for (int j = 0; j < 4; ++j) { v[j] = mr[64 * j]; s += (v[j].x * v[j].x + v[j].y * v[j].y) + (v[j].z * v[j].z + v[j].w * v[j].w); }
            const float rstd = 1.f / sqrtf(wave_sum(s) * (1.f / D) + EPS);
            f32x4* orow = (f32x4*)(out + (size_t)m * D) + lane;
#pragma unroll
            for (int j = 0; j < 4; ++j) { x[j] = x[j] + v[j] * rstd * gr[64 * j]; orow[64 * j] = x[j]; }
        }
        if (MODE != 2) {
            float s2 = 0.f;
#pragma unroll
            for (int j = 0; j < 4; ++j) s2 += (x[j].x * x[j].x + x[j].y * x[j].y) + (x[j].z * x[j].z + x[j].w * x[j].w);
            const float r2 = 1.f / sqrtf(wave_sum(s2) * (1.f / D) + EPS);
            unsigned long long* o8 = (unsigned long long*)(XN + (size_t)m * D) + lane;
#pragma unroll
            for (int j = 0; j < 4; ++j) o8[64 * j] = (unsigned long long)pk2(x[j].x * r2, x[j].y * r2) | ((unsigned long long)pk2(x[j].z * r2, x[j].w * r2) << 32);
        }
    }
}


template <int layer>
__device__ __forceinline__ void layer_body(LAS unsigned char* lds, cg::grid_group& grid, int G, int bx, int vcu, int gw, int NGW, int lane) {
#define WSB (get_args()->ws)
#define XN ((bf16*)(WSB + WS_XN))
#define QK ((bf16*)(WSB + WS_QK))
#define VT ((bf16*)(WSB + WS_VT))
#define HB ((bf16*)(WSB + WS_H))
#define MF ((float*)(WSB + WS_MF))
#define Wqk ((const bf16*)(WSB + (layer ? WS_WQK1 : WS_WQK0)))
#define Wv ((const bf16*)(WSB + (layer ? WS_WV1 : WS_WV0)))
#define Wo ((const bf16*)(WSB + (layer ? WS_WO1 : WS_WO0)))
#define Wgu ((const bf16*)(WSB + (layer ? WS_WGU1 : WS_WGU0)))
#define Wd ((const bf16*)(WSB + (layer ? WS_WD1 : WS_WD0)))
    {
        pg8::Gemm g{XN, Wqk, M, 2048, D, D, D}; pg8::StaticOrder S; S.init(M, 2048, G, bx);
#ifndef NO_G1
        pg8::EpiBf16<layer == 0> E{QK, 2048, (const float*)(WSB + WS_ROPE)}; pg8::gemm_phase<pg8::EpiBf16<layer == 0>, pg8::StaticOrder, true, true>(lds, g, S, E);
#endif
#ifndef NO_GV
        pg8::Gemm g2{Wv, XN, 1024, M, D, D, D}; pg8::StaticOrder S2; S2.init(1024, M, G, bx);
        pg8::EpiBf16<false> E2{VT, M, nullptr}; pg8::gemm_phase<pg8::EpiBf16<false>, pg8::StaticOrder, true, true>(lds, g2, S2, E2);
#endif
    }
    grid.sync();
    if (layer == 0) {
        KArgs ka = get_args();
        float d1 = wave_sum(ka->in[3][lane] * ka->in[4][lane]), d2 = wave_sum(ka->in[5][lane] * ka->in[6][lane]);
        const float lam = expf(d1) - expf(d2) + 0.2f;
#ifndef NO_DIFF
        for (int p = vcu; p < 256; p += G) { const int bh = p >> 3, s = p & 7;
            att::diff_unit(lds, QK, VT, QK, bh >> 3, bh & 7, s, lam, get_args()->in[7], 0.8f);
            att::diff_unit(lds, QK, VT, QK, bh >> 3, bh & 7, 15 - s, lam, get_args()->in[7], 0.8f); }
#endif
    } else {
#ifndef NO_SB
        for (int p = vcu; p < 1024; p += G) { const int bh = p >> 4; att::sb_unit(lds, QK, VT, QK, bh >> 4, bh & 15, p & 15); }
#endif
    }
    grid.sync();
#ifndef NO_GO
    { pg8::Gemm g{QK, Wo, M, D, D, 2048, D}; pg8::StaticOrder S; S.init(M, D, G, bx); pg8::EpiF32 E{MF, D}; pg8::gemm_phase<pg8::EpiF32, pg8::StaticOrder, true, true>(lds, g, S, E); }
#endif
    grid.sync();
    { KArgs ka = get_args(); row_phase<1>(layer ? ka->out : ka->in[0], MF, ka->in[13] + layer * D, ka->out, XN, gw, NGW, lane); }
    grid.sync();
#ifndef NO_GU
    { pg8::Gemm g{XN, Wgu, M, 2 * FF, D, D, D}; pg8::StaticOrder S; S.init(M, 2 * FF, G, bx); pg8::EpiSwiglu E{HB, FF}; pg8::gemm_phase<pg8::EpiSwiglu, pg8::StaticOrder, true, true>(lds, g, S, E); }
#endif
    grid.sync();
#ifndef NO_GD
    { pg8::Gemm g{HB, Wd, M, D, FF, FF, FF}; pg8::StaticOrder S; S.init(M, D, G, bx); pg8::EpiF32 E{MF, D}; pg8::gemm_phase<pg8::EpiF32, pg8::StaticOrder, true, true>(lds, g, S, E); }
#endif
    grid.sync();
    { KArgs ka = get_args(); if (layer == 0) row_phase<1>(ka->out, MF, ka->in[15], ka->out, XN, gw, NGW, lane);
      else row_phase<2>(ka->out, MF, ka->in[15] + D, ka->out, XN, gw, NGW, lane); }
    if (layer == 0) grid.sync();
#undef XN
#undef QK
#undef VT
#undef HB
#undef MF
#undef Wqk
#undef Wv
#undef Wo
#undef Wgu
#undef Wd
#undef WSB
}

__global__ void __launch_bounds__(NWAVES * 64, 2) fwd_mega(Args a) {
    extern __shared__ __attribute__((aligned(16))) unsigned char lds_raw[];
    cg::grid_group grid = cg::this_grid();
    LAS unsigned char* lds = (LAS unsigned char*)lds_raw;
    const int tid = threadIdx.x, lane = tid & 63, wave = __builtin_amdgcn_readfirstlane(tid >> 6);
    const int G = gridDim.x, bx = blockIdx.x;
    const int vcu = (G % 8 == 0) ? (bx % 8) * (G / 8) + bx / 8 : bx;
    const int gw = vcu * NWAVES + wave, NGW = G * NWAVES;

    {
        KArgs ka = get_args(); unsigned char* ws = ka->ws; bf16* XN = (bf16*)(ws + WS_XN); float* rope = (float*)(ws + WS_ROPE); const float* x = ka->in[0];
        LAS float* scr = (LAS float*)(lds + wave * 16384);
        int total = 0;
        for (int s = 0; s < NSEG; ++s) { const Seg sg = make_seg(ka, s); total += (sg.K / 64) * (sg.nout / 32); }
        for (int it0 = gw; it0 < total; it0 += NGW) {
            int it = it0;
            for (int s = 0; s < NSEG; ++s) { const Seg sg = make_seg(ka, s); const int nblk = sg.nout / 32, n_it = (sg.K / 64) * nblk;
                if (it < n_it) { const int kb = it / nblk, nb = it % nblk, d0 = 32 * nb;
                    int scol = sg.scol + d0;
                    if (sg.mode == 1) { const int pn = d0 >> 8, bj = (d0 >> 7) & 1, jj = d0 & 127; scol = bj * FF + 128 * pn + jj; }
                    const float sc = sg.scale;
                    tr_item(sg.W, sg.ldw, scol, 64 * kb, sg.g, sc, sg.dst, sg.K, d0, scr, lane); break; }
                it -= n_it; }
        }
        const float invf[8] = {1.0f, 0.1939227432012558f, 0.03760603070259094f, 0.007292664609849453f, 0.0014142135623842478f, 0.00027424818836152554f, 5.3182957344688475e-05f, 1.0313385246263351e-05f};
        for (int idx = bx * (NWAVES * 64) + tid; idx < SEQ * 8; idx += G * NWAVES * 64) {
            const int pos = idx >> 3, i = idx & 7;
            float fr = 1.0f;
#pragma unroll
            for (int k = 0; k < 8; ++k) if (i == k) fr = invf[k];
            const float angf = (float)pos * fr; const double ang = (double)angf;
            const double kq = __builtin_rint(ang * 0.63661977236758134308); const long kk = (long)kq;
            const double r = (ang - kq * 1.57079632679489655800) - kq * 6.12323399573676603587e-17;
            const double r2 = r * r;
            const double sn = r * (1.0 + r2 * (-1.0 / 6 + r2 * (1.0 / 120 + r2 * (-1.0 / 5040 + r2 * (1.0 / 362880 + r2 * (-1.0 / 39916800 + r2 * (1.0 / 6227020800.0)))))));
            const double cs = 1.0 + r2 * (-0.5 + r2 * (1.0 / 24 + r2 * (-1.0 / 720 + r2 * (1.0 / 40320 + r2 * (-1.0 / 3628800 + r2 * (1.0 / 479001600.0))))));
            const int qd = (int)(kk & 3);
            const double c = (qd == 0) ? cs : (qd == 1) ? -sn : (qd == 2) ? -cs : sn;
            const double s = (qd == 0) ? sn : (qd == 1) ? cs : (qd == 2) ? -sn : -cs;
            rope[pos * 16 + i] = (float)c; rope[pos * 16 + 8 + i] = (float)s;
        }
        row_phase<0>(x, nullptr, nullptr, nullptr, XN, gw, NGW, lane);
    }
    grid.sync();

    layer_body<0>(lds, grid, G, bx, vcu, gw, NGW, lane);
    layer_body<1>(lds, grid, G, bx, vcu, gw, NGW, lane);
}

extern "C" void kernel_launch(void* const* d_in, const int* in_sizes, int n_in, void* d_out, int out_size, void* d_ws, size_t ws_size, hipStream_t stream) {
    static int grid = 0;
    if (grid == 0) {
        if (n_in != 18 || in_sizes[0] != M * D || out_size != M * D || ws_size < WS_END) { fprintf(stderr, "kernel_launch: unexpected shapes (n_in %d, in0 %d, out %d, ws %zu)\n", n_in, n_in > 0 ? in_sizes[0] : -1, out_size, ws_size); grid = -1; return; }
        int dev = 0, cus = 0, per_cu = 0;
        hipGetDevice(&dev); hipDeviceGetAttribute(&cus, hipDeviceAttributeMultiprocessorCount, dev);
        if (hipFuncSetAttribute((const void*)fwd_mega, hipFuncAttributeMaxDynamicSharedMemorySize, LDS_BYTES) != hipSuccess) { fprintf(stderr, "kernel_launch: hipFuncSetAttribute failed\n"); grid = -1; return; }
        if (hipOccupancyMaxActiveBlocksPerMultiprocessor(&per_cu, (const void*)fwd_mega, NWAVES * 64, LDS_BYTES) != hipSuccess || per_cu < 1) { fprintf(stderr, "kernel_launch: occupancy query says %d\n", per_cu); per_cu = 1; }
        (void)hipGetLastError();
        grid = cus * 1;
    }
    if (grid < 0) return;
    Args a{};
    for (int i = 0; i < 18; ++i) a.in[i] = (const float*)d_in[i];
    a.out = (float*)d_out; a.ws = (unsigned char*)d_ws;
    void* args[] = {&a};
    hipError_t e = hipLaunchCooperativeKernel((const void*)fwd_mega, dim3(grid), dim3(NWAVES * 64), args, LDS_BYTES, stream);
    if (e != hipSuccess) fprintf(stderr, "kernel_launch: cooperative launch failed: %s (grid %d)\n", hipGetErrorString(e), grid);
}
```

```cpp
#include <hip/hip_runtime.h>
#include <hip/hip_cooperative_groups.h>
#include <cstdio>
#include <cstdint>
#include <cmath>
namespace cg = cooperative_groups;
namespace pg8 {
#define PG8_LAS __attribute__((address_space(3)))
typedef unsigned short bf16_t;
typedef short bf16x8 __attribute__((ext_vector_type(8)));
typedef float f32x4 __attribute__((ext_vector_type(4)));
typedef unsigned u32x4 __attribute__((ext_vector_type(4)));
constexpr int BM = 256, BK = 64, HALF = 128, HTB = HALF * BK * 2  , STAGE_BYTES = 8 * HTB, NXCD = 8, WGM = 8;

__host__ __device__ __forceinline__ int lds_byte(int r, int c) { const int st = (r >> 4) * 2 + (c >> 5), rr = r & 15, cc = c & 31, ob = rr * 64 + cc * 2; return st * 1024 + (ob ^ (((ob >> 9) & 1) << 5)); }
__host__ __device__ __forceinline__ void stage_rc(int b, int& R, int& C) { const int st = b / 1024, sb = b % 1024, swz = sb ^ (((sb >> 9) & 1) << 5); R = (st >> 1) * 16 + swz / 64; C = (st & 1) * 32 + (swz % 64) / 2; }
__host__ __device__ __forceinline__ int perm32(int rho) { const int n = rho >> 4, i = rho & 15; return 8 * (i >> 2) + 4 * n + (i & 3); }

struct Unit { int pm, pn; };
struct Gemm { const bf16_t* A; const bf16_t* Bt; int M, N, K, lda, ldb; };

struct StaticOrder {
    int nM, nN, nwg, G, c;
    __host__ __device__ void init(int M, int N, int G_, int c_) { nM = M / BM; nN = N / BM; nwg = nM * nN; G = G_; c = c_; }
    __host__ __device__ bool next(int i, Unit& u) const {
        const long L = (long)i * G + c; if (L >= nwg) return false;
        int wgid = (int)L; { const int q = nwg / NXCD, r = nwg % NXCD, xcd = wgid % NXCD, off = wgid / NXCD; wgid = (xcd < r ? xcd * (q + 1) : r * (q + 1) + (xcd - r) * q) + off; }
        const int nig = WGM * nN, gid = wgid / nig, fm = gid * WGM, gsz = (nM - fm) < WGM ? (nM - fm) : WGM;
        u.pm = fm + ((wgid % nig) % gsz); u.pn = (wgid % nig) / gsz; return true;
    }
    __device__ __forceinline__ void a_ready(const Unit&) const {}
    __device__ __forceinline__ void done(const Unit&) const {}
};
__device__ __forceinline__ unsigned cvt_pk_bf16(float lo, float hi) { unsigned r; asm volatile("v_cvt_pk_bf16_f32 %0, %1, %2" : "=v"(r) : "v"(lo), "v"(hi)); return r; }
typedef float f32x2 __attribute__((ext_vector_type(2)));
template <bool ROPE> struct EpiBf16 {
    static constexpr bool PERM = true, AFTER_DRAIN = false;
    bf16_t* O; int ldc; const float* rope;
    __device__ __forceinline__ void operator()(const f32x4 (&acc)[2][2][4][2], const Unit& u, int wr, int wc, int fr, int fq) const {
        const int row0 = u.pm * BM + wr * 64 + fr; const int col0 = u.pn * BM + wc * 32 + 8 * fq;
        const bool rot = ROPE && ((wc & 1) == 0);
        const float sgn = (fq == 0) ? -1.f : 1.f;
#pragma unroll
        for (int ai = 0; ai < 2; ++ai)
#pragma unroll
            for (int m = 0; m < 4; ++m) { const int row = row0 + ai * HALF + m * 16; bf16_t* rowp = O + (size_t)row * ldc + col0;
                f32x4 c0 = {1.f, 1.f, 1.f, 1.f}, c1 = c0, s0 = {0.f, 0.f, 0.f, 0.f}, s1 = s0;
                if (ROPE) { if (rot && fq < 2) { const float* rp = rope + (size_t)(row & 4095) * 16; c0 = *(const f32x4*)(rp); c1 = *(const f32x4*)(rp + 4); s0 = *(const f32x4*)(rp + 8) * sgn; s1 = *(const f32x4*)(rp + 12) * sgn; } }
#pragma unroll
                for (int bj = 0; bj < 2; ++bj) { f32x4 v0 = acc[ai][bj][m][0], v1 = acc[ai][bj][m][1];
                    if (ROPE) { if (rot) { f32x4 p0, p1;
#pragma unroll
                            for (int e = 0; e < 4; ++e) { p0[e] = __shfl_xor(v0[e], 16); p1[e] = __shfl_xor(v1[e], 16); }
                            v0 = v0 * c0 + p0 * s0; v1 = v1 * c1 + p1 * s1; } }
                    u32x4 w; w.x = cvt_pk_bf16(v0[0], v0[1]); w.y = cvt_pk_bf16(v0[2], v0[3]); w.z = cvt_pk_bf16(v1[0], v1[1]); w.w = cvt_pk_bf16(v1[2], v1[3]);
                    *(u32x4*)(rowp + bj * HALF) = w; } }
    }
};
struct EpiSwiglu {
    static constexpr bool PERM = true, AFTER_DRAIN = false;
    bf16_t* O; int ldc;
    __device__ __forceinline__ static float sw(float g, float up) { return g * up * __builtin_amdgcn_rcpf(1.f + __builtin_amdgcn_exp2f(-1.4426950408889634f * g)); }
    __device__ __forceinline__ void operator()(const f32x4 (&acc)[2][2][4][2], const Unit& u, int wr, int wc, int fr, int fq) const {
        const int row0 = u.pm * BM + wr * 64 + fr; const int col0 = u.pn * HALF + wc * 32 + 8 * fq;
#pragma unroll
        for (int ai = 0; ai < 2; ++ai)
#pragma unroll
            for (int m = 0; m < 4; ++m) { bf16_t* rowp = O + (size_t)(row0 + ai * HALF + m * 16) * ldc + col0;
                const f32x4 g0 = acc[ai][0][m][0], g1 = acc[ai][0][m][1], u0 = acc[ai][1][m][0], u1 = acc[ai][1][m][1];
                u32x4 w; w.x = cvt_pk_bf16(sw(g0[0], u0[0]), sw(g0[1], u0[1])); w.y = cvt_pk_bf16(sw(g0[2], u0[2]), sw(g0[3], u0[3]));
                w.z = cvt_pk_bf16(sw(g1[0], u1[0]), sw(g1[1], u1[1])); w.w = cvt_pk_bf16(sw(g1[2], u1[2]), sw(g1[3], u1[3]));
                *(u32x4*)rowp = w; }
    }
};
struct EpiF32 {
    static constexpr bool PERM = false, AFTER_DRAIN = false;
    float* O; int ldc;
    __device__ __forceinline__ void operator()(const f32x4 (&acc)[2][2][4][2], const Unit& u, int wr, int wc, int fr, int fq) const {
        const int row0 = u.pm * BM + wr * 64 + fr; const int col0 = u.pn * BM + wc * 32 + 4 * fq;
#pragma unroll
        for (int ai = 0; ai < 2; ++ai)
#pragma unroll
            for (int m = 0; m < 4; ++m) { float* rowp = O + (size_t)(row0 + ai * HALF + m * 16) * ldc + col0;
#pragma unroll
                for (int bj = 0; bj < 2; ++bj)
#pragma unroll
                    for (int n = 0; n < 2; ++n) *(f32x4*)(rowp + bj * HALF + n * 16) = acc[ai][bj][m][n]; }
    }
};
template <class Epi, class Sched, bool ALIGN_EPI = false, bool SP2 = false>
__device__ __forceinline__ void gemm_phase(PG8_LAS unsigned char* lds, const Gemm g, const Sched& S, const Epi& E) {
    int tid_ = threadIdx.x; asm volatile("" : "+v"(tid_));
    const int tid = tid_, wid = __builtin_amdgcn_readfirstlane(tid >> 6), lane = tid & 63, wr = wid >> 2, wc = wid & 3, fr = lane & 15, fq = lane >> 4;
    const int K = g.K, nt = K / BK;
    unsigned voffA[2], voffB[2];
#pragma unroll
    for (int i = 0; i < 2; ++i) { int R, C; stage_rc(tid * 16 + i * 8192, R, C); const int Rb = Epi::PERM ? ((R & ~31) + perm32(R & 31)) : R;
        voffA[i] = (unsigned)(R * g.lda + C) * 2u; voffB[i] = (unsigned)(Rb * g.ldb + C) * 2u; }
    const size_t kstep = (size_t)(BK * 2);
    const size_t hstepA = (size_t)HALF * g.lda * 2, hstepB = (size_t)HALF * g.ldb * 2;
    const size_t tstepA = 2 * hstepA, tstepB = 2 * hstepB;
    const unsigned ldsw = (unsigned)wid * 1024u;
    const int aoff = lds_byte(wr * 64 + fr, fq * 8), boff = lds_byte(wc * 32 + fr, fq * 8);
#define PG8_SA(b, h) (((b) * 2 + (h)) * HTB)
#define PG8_SB(b, h) ((4 + (b) * 2 + (h)) * HTB)
#define PG8_STAGE(bufoff, gbase, voff) do { _Pragma("unroll") for (int _i = 0; _i < 2; ++_i) \
        __builtin_amdgcn_global_load_lds((const unsigned*)((const char*)(gbase) + (voff)[_i]), (PG8_LAS unsigned*)(lds + (bufoff) + ldsw + _i * 8192), 16, 0, 0); } while (0)
#define PG8_LDA(dst, b, h) do { _Pragma("unroll") for (int m = 0; m < 4; ++m) _Pragma("unroll") for (int k = 0; k < 2; ++k) dst[m][k] = *(const PG8_LAS bf16x8*)(lds + PG8_SA(b, h) + aoff + m * 2048 + k * 1024); } while (0)
#define PG8_LDB(dst, b, h) do { _Pragma("unroll") for (int n = 0; n < 2; ++n) _Pragma("unroll") for (int k = 0; k < 2; ++k) dst[n][k] = *(const PG8_LAS bf16x8*)(lds + PG8_SB(b, h) + boff + n * 2048 + k * 1024); } while (0)
#define PG8_MMA(ai, bj, At, Bt) do { __builtin_amdgcn_s_setprio(1); _Pragma("unroll") for (int m = 0; m < 4; ++m) _Pragma("unroll") for (int n = 0; n < 2; ++n) _Pragma("unroll") for (int k = 0; k < 2; ++k) \
        acc[ai][bj][m][n] = __builtin_amdgcn_mfma_f32_16x16x32_bf16(Bt[n][k], At[m][k], acc[ai][bj][m][n], 0, 0, 0); __builtin_amdgcn_s_setprio(0); } while (0)
#define PG8_WAIT_V(n) asm volatile("s_waitcnt vmcnt(" #n ")" ::: "memory")
#define PG8_WAIT_L(n) asm volatile("s_waitcnt lgkmcnt(" #n ")" ::: "memory")
#define PG8_BAR __builtin_amdgcn_s_barrier()
#define PG8_SCHED __builtin_amdgcn_sched_barrier(0)
    Unit cur, nxt; int ui = 0;
    if (!S.next(0, cur)) return;
    f32x4 acc[2][2][4][2];
#pragma unroll
    for (int a = 0; a < 2; ++a)
#pragma unroll
        for (int b = 0; b < 2; ++b)
#pragma unroll
            for (int m = 0; m < 4; ++m)
#pragma unroll
                for (int n = 0; n < 2; ++n) acc[a][b][m][n] = (f32x4){0.f, 0.f, 0.f, 0.f};
    bf16x8 At[4][2], B0[2][2], B1[2][2];
    const char* cA = (const char*)g.A + (size_t)cur.pm * tstepA; const char* cB = (const char*)g.Bt + (size_t)cur.pn * tstepB;
    S.a_ready(cur);
    if constexpr (SP2) {
        PG8_STAGE(PG8_SB(0, 0), cB, voffB); PG8_STAGE(PG8_SB(0, 1), cB + hstepB, voffB); PG8_STAGE(PG8_SA(0, 0), cA, voffA); PG8_STAGE(PG8_SA(0, 1), cA + hstepA, voffA);
        if (wr == 1) PG8_BAR;
        PG8_WAIT_V(2); PG8_BAR;
        PG8_STAGE(PG8_SB(1, 0), cB + kstep, voffB); PG8_STAGE(PG8_SA(1, 0), cA + kstep, voffA); PG8_STAGE(PG8_SB(1, 1), cB + hstepB + kstep, voffB);
        PG8_WAIT_V(6); PG8_BAR;
    } else {
        PG8_STAGE(PG8_SB(0, 0), cB, voffB); PG8_STAGE(PG8_SA(0, 0), cA, voffA); PG8_STAGE(PG8_SB(0, 1), cB + hstepB, voffB); PG8_STAGE(PG8_SA(0, 1), cA + hstepA, voffA);
        if (wr == 1) PG8_BAR;
        PG8_WAIT_V(4); PG8_BAR;
        PG8_STAGE(PG8_SB(1, 0), cB + kstep, voffB); PG8_STAGE(PG8_SA(1, 0), cA + kstep, voffA); PG8_STAGE(PG8_SB(1, 1), cB + hstepB + kstep, voffB);
        PG8_WAIT_V(6); PG8_BAR;
    }
    for (;;) {
        const bool has_next = S.next(ui + 1, nxt);
        const char* nA = has_next ? (const char*)g.A + (size_t)nxt.pm * tstepA : cA; const char* nB = has_next ? (const char*)g.Bt + (size_t)nxt.pn * tstepB : cB;
        for (int t = 0; t < nt; t += 2) {
            const bool last = (t == nt - 2);
            const char* a1 = cA + (size_t)(t + 1) * kstep;
            const char* a2 = last ? nA : cA + (size_t)(t + 2) * kstep; const char* b2 = last ? nB : cB + (size_t)(t + 2) * kstep;
            const char* a3 = a2 + kstep; const char* b3 = b2 + kstep;
            if (last && has_next) S.a_ready(nxt);
            if constexpr (SP2) {
            PG8_LDB(B0, 0, 0); PG8_LDB(B1, 0, 1); PG8_SCHED; PG8_LDA(At, 0, 0); PG8_STAGE(PG8_SA(1, 1), a1 + hstepA, voffA);
            PG8_WAIT_V(8); PG8_WAIT_L(0); PG8_BAR; PG8_MMA(0, 0, At, B0); PG8_MMA(0, 1, At, B1); PG8_BAR; PG8_SCHED;
            PG8_LDA(At, 0, 1); PG8_STAGE(PG8_SB(0, 0), b2, voffB); PG8_STAGE(PG8_SB(0, 1), b2 + hstepB, voffB); PG8_STAGE(PG8_SA(0, 0), a2, voffA);
            PG8_WAIT_V(8); PG8_WAIT_L(0); PG8_BAR; PG8_MMA(1, 0, At, B0); PG8_MMA(1, 1, At, B1); PG8_BAR; PG8_SCHED;
            PG8_LDB(B0, 1, 0); PG8_LDB(B1, 1, 1); PG8_SCHED; PG8_LDA(At, 1, 0); PG8_STAGE(PG8_SA(0, 1), a2 + hstepA, voffA);
            PG8_WAIT_V(8); PG8_WAIT_L(0); PG8_BAR; PG8_MMA(0, 0, At, B0); PG8_MMA(0, 1, At, B1); PG8_BAR; PG8_SCHED;
            PG8_LDA(At, 1, 1); PG8_STAGE(PG8_SB(1, 0), b3, voffB); PG8_STAGE(PG8_SB(1, 1), b3 + hstepB, voffB); PG8_STAGE(PG8_SA(1, 0), a3, voffA);
            PG8_WAIT_V(8); PG8_WAIT_L(0); PG8_BAR; PG8_MMA(1, 0, At, B0); PG8_MMA(1, 1, At, B1); PG8_BAR; PG8_SCHED;
            } else {
            PG8_LDB(B0, 0, 0); PG8_SCHED; PG8_LDA(At, 0, 0); PG8_STAGE(PG8_SA(1, 1), a1 + hstepA, voffA);
            PG8_WAIT_L(8); PG8_BAR; PG8_WAIT_L(0); PG8_MMA(0, 0, At, B0); PG8_BAR; PG8_SCHED;
            PG8_LDB(B1, 0, 1); PG8_STAGE(PG8_SB(0, 0), b2, voffB);
            PG8_BAR; PG8_WAIT_L(0); PG8_MMA(0, 1, At, B1); PG8_BAR;
            PG8_LDA(At, 0, 1); PG8_STAGE(PG8_SA(0, 0), a2, voffA);
            PG8_BAR; PG8_WAIT_L(0); PG8_MMA(1, 0, At, B0); PG8_BAR; PG8_SCHED;
            PG8_STAGE(PG8_SB(0, 1), b2 + hstepB, voffB);
            PG8_WAIT_V(6); PG8_BAR; PG8_MMA(1, 1, At, B1); PG8_BAR;
            PG8_LDB(B0, 1, 0); PG8_SCHED; PG8_LDA(At, 1, 0); PG8_STAGE(PG8_SA(0, 1), a2 + hstepA, voffA);
            PG8_WAIT_L(8); PG8_BAR; PG8_WAIT_L(0); PG8_MMA(0, 0, At, B0); PG8_BAR; PG8_SCHED;
            PG8_LDB(B1, 1, 1); PG8_STAGE(PG8_SB(1, 0), b3, voffB);
            PG8_BAR; PG8_WAIT_L(0); PG8_MMA(0, 1, At, B1); PG8_BAR;
            PG8_LDA(At, 1, 1); PG8_STAGE(PG8_SA(1, 0), a3, voffA);
            PG8_BAR; PG8_WAIT_L(0); PG8_MMA(1, 0, At, B0); PG8_BAR; PG8_SCHED;
            PG8_STAGE(PG8_SB(1, 1), b3 + hstepB, voffB);
            PG8_WAIT_V(6); PG8_BAR; PG8_MMA(1, 1, At, B1); PG8_BAR;
            }
        }
        if constexpr (ALIGN_EPI) { if (wr == 0) PG8_BAR; }
        if constexpr (!Epi::AFTER_DRAIN) { E(acc, cur, wr, wc, fr, fq); S.done(cur); }
        if (!has_next) break;
#pragma unroll
        for (int a = 0; a < 2; ++a)
#pragma unroll
            for (int b = 0; b < 2; ++b)
#pragma unroll
                for (int m = 0; m < 4; ++m)
#pragma unroll
                    for (int n = 0; n < 2; ++n) acc[a][b][m][n] = (f32x4){0.f, 0.f, 0.f, 0.f};
        cur = nxt; cA = nA; cB = nB; ++ui;
        if constexpr (ALIGN_EPI) { if (wr == 1) PG8_BAR; }
    }
    PG8_WAIT_V(0);
    if constexpr (!ALIGN_EPI) { if (wr == 0) PG8_BAR; }
    PG8_BAR;
    if constexpr (Epi::AFTER_DRAIN) { E.fused(acc, cur, wr, wc, fr, fq, lds, wid, lane); S.done(cur); }
#undef PG8_SA
#undef PG8_SB
#undef PG8_STAGE
#undef PG8_LDA
#undef PG8_LDB
#undef PG8_MMA
#undef PG8_WAIT_V
#undef PG8_WAIT_L
#undef PG8_BAR
#undef PG8_SCHED
}
}

namespace att {
#define ALAS __attribute__((address_space(3)))
typedef short bf16x8 __attribute__((ext_vector_type(8)));
typedef float f32x16 __attribute__((ext_vector_type(16)));
typedef float f32x4 __attribute__((ext_vector_type(4)));
typedef unsigned u32x4 __attribute__((ext_vector_type(4)));
typedef unsigned short bf16_t;
constexpr int SEQ = 4096, LDQ = 2048, LDV = 16384;
constexpr int KP = 144, VP = 144, KBUF = 64 * KP, VBUF = 128 * VP;
constexpr int OFF_K = 0, OFF_V = 2 * KBUF, OFF_WSF = OFF_V + 2 * VBUF, OFF_OST = OFF_WSF + 8 * 256, LDS_BYTES = OFF_OST + 8 * 8192;
__device__ __forceinline__ unsigned cvtpk(float lo, float hi) { unsigned r; asm("v_cvt_pk_bf16_f32 %0, %1, %2" : "=v"(r) : "v"(lo), "v"(hi)); return r; }
__device__ __forceinline__ float swap_max(float m) { auto rr = __builtin_amdgcn_permlane32_swap(__float_as_uint(m), __float_as_uint(m), false, false); return fmaxf(__uint_as_float(rr[0]), __uint_as_float(rr[1])); }
__device__ __forceinline__ float swap_sum(float m) { auto rr = __builtin_amdgcn_permlane32_swap(__float_as_uint(m), __float_as_uint(m), false, false); return __uint_as_float(rr[0]) + __uint_as_float(rr[1]); }
__device__ __forceinline__ float swap_other(float m, int hi) { auto rr = __builtin_amdgcn_permlane32_swap(__float_as_uint(m), __float_as_uint(m), false, false); return __uint_as_float(hi ? rr[0] : rr[1]); }
#define MFMA32(a, b, c) __builtin_amdgcn_mfma_f32_32x32x16_bf16((a), (b), (c), 0, 0, 0)


__device__ __forceinline__ void diff_unit(ALAS unsigned char* lds, const bf16_t* QK, const bf16_t* VT, bf16_t* O, int b, int hp, int u, float lam, const float* subg, float outscale) {
    int tid_ = threadIdx.x; asm volatile("" : "+v"(tid_));
    const int tid = tid_, lane = tid & 63, r32 = lane & 31, hi = lane >> 5, w = __builtin_amdgcn_readfirstlane(tid >> 6);
    const int q0 = 256 * u, NT = 4 * u + 4, qrel = 32 * w + r32;
    const size_t rowbase = (size_t)b * SEQ;
    ALAS float* wsf = (ALAS float*)(lds + OFF_WSF) + w * 64;
    const int srow = tid >> 3, sch = tid & 7;
    const int kperm = (r32 & ~12) | ((r32 & 4) << 1) | ((r32 & 8) >> 1);
    const unsigned kst = (unsigned)(srow * KP + sch * 16), vst = (unsigned)(srow * VP + sch * 16);
    unsigned svp[4][8];
#pragma unroll 1
    for (int hh = 0; hh < 2; ++hh) {
        const int hq = 2 * hp + hh;
        const bf16_t* Qw = QK + (rowbase + q0 + 32 * w + r32) * LDQ + hq * 64 + hi * 8;
        bf16x8 qr[4];
#pragma unroll
        for (int d0 = 0; d0 < 4; ++d0) qr[d0] = *(const bf16x8*)(Qw + d0 * 16);
        const bf16_t* Kg = QK + (rowbase + srow) * LDQ + 1024 + hq * 64 + sch * 8;
        const bf16_t* Vg = VT + (size_t)(hp * 128 + srow) * LDV + rowbase + sch * 8;
        u32x4 kr = *(const u32x4*)Kg, v0 = *(const u32x4*)Vg, v1 = *(const u32x4*)(Vg + (size_t)64 * LDV);
        *(ALAS u32x4*)(lds + OFF_K + kst) = kr; *(ALAS u32x4*)(lds + OFF_V + vst) = v0; *(ALAS u32x4*)(lds + OFF_V + 64 * VP + vst) = v1;
        __syncthreads();
        float mhat = 0.f, l = 0.f; f32x16 o[4]; f32x16 zero16;
#pragma unroll
        for (int i = 0; i < 4; ++i)
#pragma unroll
            for (int r = 0; r < 16; ++r) o[i][r] = 0.f;
#pragma unroll
        for (int r = 0; r < 16; ++r) zero16[r] = 0.f;
#pragma unroll 1
        for (int t = 0; t < NT; ++t) {
            const int buf = t & 1; const bool more = (t + 1 < NT);
            if (more) { kr = *(const u32x4*)(Kg + (size_t)(t + 1) * 64 * LDQ); v0 = *(const u32x4*)(Vg + (t + 1) * 64); v1 = *(const u32x4*)(Vg + (size_t)64 * LDV + (t + 1) * 64); }
            const int jb = t - (NT - 4);
            if (!(jb >= 0 && 64 * jb > 32 * w + 31)) {
                const ALAS unsigned char* Kl = lds + OFF_K + buf * KBUF + kperm * KP + hi * 16;
                f32x16 p0, p1;
#pragma unroll
                for (int d0 = 0; d0 < 4; ++d0) { const bf16x8 a0 = *(const ALAS bf16x8*)(Kl + d0 * 32), a1 = *(const ALAS bf16x8*)(Kl + 32 * KP + d0 * 32);
                    if (d0 == 0) { p0 = MFMA32(a0, qr[0], zero16); p1 = MFMA32(a1, qr[0], zero16); } else { p0 = MFMA32(a0, qr[d0], p0); p1 = MFMA32(a1, qr[d0], p1); } }
                if (jb >= 0) { const int kb0 = 64 * jb + 8 * hi;
#pragma unroll
                    for (int r = 0; r < 16; ++r) { const int key = kb0 + 16 * (r >> 3) + (r & 7); if (key > qrel) p0[r] = -INFINITY; if (key + 32 > qrel) p1[r] = -INFINITY; } }
                float rm = fmaxf(p0[0], p1[0]);
#pragma unroll
                for (int r = 1; r < 16; ++r) rm = fmaxf(rm, fmaxf(p0[r], p1[r]));
                rm = swap_max(rm);
                if (t == 0) { mhat = rm; }
                else if (__any(rm - mhat > 8.f)) {
                    const float dl = fmaxf(rm - mhat, 0.f); mhat += dl;
                    const float f = __builtin_amdgcn_exp2f(-dl); l *= f; if (hi == 0) wsf[r32] = f;
#pragma unroll
                    for (int g = 0; g < 4; ++g) { const f32x4 f4 = *(const ALAS f32x4*)(wsf + 8 * g + 4 * hi);
#pragma unroll
                        for (int i = 0; i < 4; ++i)
#pragma unroll
                            for (int e = 0; e < 4; ++e) o[i][4 * g + e] *= f4[e]; }
                }
                float ls = 0.f;
#pragma unroll
                for (int r = 0; r < 16; ++r) { p0[r] = __builtin_amdgcn_exp2f(p0[r] - mhat); p1[r] = __builtin_amdgcn_exp2f(p1[r] - mhat); ls += p0[r] + p1[r]; }
                l += ls;
                bf16x8 pa[4];
#pragma unroll
                for (int uu = 0; uu < 2; ++uu) { u32x4 a, c; a.x = cvtpk(p0[8 * uu], p0[8 * uu + 1]); a.y = cvtpk(p0[8 * uu + 2], p0[8 * uu + 3]); a.z = cvtpk(p0[8 * uu + 4], p0[8 * uu + 5]); a.w = cvtpk(p0[8 * uu + 6], p0[8 * uu + 7]);
                    c.x = cvtpk(p1[8 * uu], p1[8 * uu + 1]); c.y = cvtpk(p1[8 * uu + 2], p1[8 * uu + 3]); c.z = cvtpk(p1[8 * uu + 4], p1[8 * uu + 5]); c.w = cvtpk(p1[8 * uu + 6], p1[8 * uu + 7]);
                    pa[uu] = __builtin_bit_cast(bf16x8, a); pa[2 + uu] = __builtin_bit_cast(bf16x8, c); }
                const ALAS unsigned char* Vl = lds + OFF_V + buf * VBUF + r32 * VP + hi * 16;
                bf16x8 vb[2][4];
#pragma unroll
                for (int g = 0; g < 4; ++g) vb[0][g] = *(const ALAS bf16x8*)(Vl + g * 32);
                __builtin_amdgcn_sched_barrier(0);
#pragma unroll
                for (int i = 0; i < 4; ++i) {
                    if (i < 3) {
#pragma unroll
                        for (int g = 0; g < 4; ++g) vb[(i + 1) & 1][g] = *(const ALAS bf16x8*)(Vl + (i + 1) * 32 * VP + g * 32); }
#pragma unroll
                    for (int g = 0; g < 4; ++g) o[i] = MFMA32(pa[g], vb[i & 1][g], o[i]);
                    __builtin_amdgcn_sched_barrier(0);
                }
            }
            if (more) { const int nb = buf ^ 1; *(ALAS u32x4*)(lds + OFF_K + nb * KBUF + kst) = kr; *(ALAS u32x4*)(lds + OFF_V + nb * VBUF + vst) = v0; *(ALAS u32x4*)(lds + OFF_V + nb * VBUF + 64 * VP + vst) = v1; }
            __syncthreads();
        }
        l = swap_sum(l);
        if (hi == 0) wsf[r32] = 1.f / l;
#pragma unroll
        for (int g = 0; g < 4; ++g) { const f32x4 f4 = *(const ALAS f32x4*)(wsf + 8 * g + 4 * hi);
#pragma unroll
            for (int i = 0; i < 4; ++i)
#pragma unroll
                for (int e = 0; e < 4; ++e) o[i][4 * g + e] *= f4[e]; }
        if (hh == 0) {
#pragma unroll
            for (int i = 0; i < 4; ++i)
#pragma unroll
                for (int j = 0; j < 8; ++j) svp[i][j] = cvtpk(o[i][2 * j], o[i][2 * j + 1]);
        } else {
            float gg[4];
#pragma unroll
            for (int i = 0; i < 4; ++i) gg[i] = subg[32 * i + r32] * outscale;
            ALAS bf16_t* stg = (ALAS bf16_t*)(lds + OFF_OST) + w * 4096;
#pragma unroll
            for (int r = 0; r < 16; ++r) {
                float c[4], part = 0.f;
#pragma unroll
                for (int i = 0; i < 4; ++i) { const float s0 = __uint_as_float((r & 1) ? (svp[i][r >> 1] & 0xffff0000u) : (svp[i][r >> 1] << 16)); c[i] = s0 - lam * o[i][r]; part += c[i] * c[i]; }
                part += __shfl_xor(part, 1); part += __shfl_xor(part, 2); part += __shfl_xor(part, 4); part += __shfl_xor(part, 8); part += __shfl_xor(part, 16);
                const float rstd = __builtin_amdgcn_rsqf(part * (1.f / 128.f) + 1e-6f);
                const int row = (r & 3) + 8 * (r >> 2) + 4 * hi;
#pragma unroll
                for (int i = 0; i < 4; ++i) stg[row * 128 + 32 * i + r32] = (bf16_t)(cvtpk(c[i] * rstd * gg[i], 0.f) & 0xffffu);
            }
            const ALAS bf16_t* sp = stg + (lane >> 4) * 128 + (lane & 15) * 8;
            bf16_t* gp = O + (rowbase + q0 + 32 * w + (lane >> 4)) * LDQ + hp * 128 + (lane & 15) * 8;
#pragma unroll 1
            for (int it = 0; it < 8; ++it) { const u32x4 v = *(const ALAS u32x4*)sp; *(u32x4*)gp = v; sp += 4 * 128; gp += 4 * LDQ; }
        }
    }
}

__device__ __forceinline__ void sb_unit(ALAS unsigned char* lds, const bf16_t* QK, const bf16_t* VT, bf16_t* O, int b, int h, int u) {
    int tid_ = threadIdx.x; asm volatile("" : "+v"(tid_));
    const int tid = tid_, lane = tid & 63, r32 = lane & 31, hi = lane >> 5, w = __builtin_amdgcn_readfirstlane(tid >> 6);
    const int q0 = 256 * u, NT = 4 * u + 4, qrel = 32 * w + r32;
    const size_t rowbase = (size_t)b * SEQ;
    const int srow = tid >> 3, sch = tid & 7;
    const int kperm = (r32 & ~12) | ((r32 & 4) << 1) | ((r32 & 8) >> 1);
    const unsigned kst = (unsigned)(srow * KP + sch * 16), vst = (unsigned)(srow * VP + sch * 16);
    const bf16_t* Qw = QK + (rowbase + q0 + 32 * w + r32) * LDQ + h * 64 + hi * 8;
    bf16x8 qr[4];
#pragma unroll
    for (int d0 = 0; d0 < 4; ++d0) qr[d0] = *(const bf16x8*)(Qw + d0 * 16);
    const bf16_t* Kg = QK + (rowbase + srow) * LDQ + 1024 + h * 64 + sch * 8;
    const bf16_t* Vg = VT + (size_t)(h * 64 + srow) * LDV + rowbase + sch * 8;
    u32x4 kr = *(const u32x4*)(Kg + (size_t)(NT - 1) * 64 * LDQ), v0 = *(const u32x4*)(Vg + (NT - 1) * 64);
    *(ALAS u32x4*)(lds + OFF_K + kst) = kr; *(ALAS u32x4*)(lds + OFF_V + vst) = v0;
    __syncthreads();
    float R = 0.f; f32x16 o[2];
#pragma unroll
    for (int i = 0; i < 2; ++i)
#pragma unroll
        for (int r = 0; r < 16; ++r) o[i][r] = 0.f;
    bool wdone = false;
#pragma unroll 1
    for (int t = NT - 1, it = 0; ; --t, ++it) {
        const int buf = it & 1; const bool more = (t > 0);
        if (more) { kr = *(const u32x4*)(Kg + (size_t)(t - 1) * 64 * LDQ); v0 = *(const u32x4*)(Vg + (t - 1) * 64); }
        const int jb = t - (NT - 4);
        if (!wdone && !(jb >= 0 && 64 * jb > 32 * w + 30)) {
            const ALAS unsigned char* Kl = lds + OFF_K + buf * KBUF + kperm * KP + hi * 16;
            f32x16 y0, y1;
#pragma unroll
            for (int r = 0; r < 16; ++r) { y0[r] = 0.f; y1[r] = 0.f; }
#pragma unroll
            for (int d0 = 0; d0 < 4; ++d0) { const bf16x8 a0 = *(const ALAS bf16x8*)(Kl + d0 * 32), a1 = *(const ALAS bf16x8*)(Kl + 32 * KP + d0 * 32);
                y0 = MFMA32(a0, qr[d0], y0); y1 = MFMA32(a1, qr[d0], y1); }
            if (jb >= 0) { const int kb0 = 64 * jb + 8 * hi;
#pragma unroll
                for (int r = 0; r < 16; ++r) { const int key = kb0 + 16 * (r >> 3) + (r & 7); if (key >= qrel) y0[r] = -INFINITY; if (key + 32 >= qrel) y1[r] = -INFINITY; } }
            f32x16 L0, L1;
#pragma unroll
            for (int r = 0; r < 16; ++r) { L0[r] = -(fmaxf(y0[r], 0.f) + __builtin_amdgcn_logf(1.f + __builtin_amdgcn_exp2f(-fabsf(y0[r])))); L1[r] = -(fmaxf(y1[r], 0.f) + __builtin_amdgcn_logf(1.f + __builtin_amdgcn_exp2f(-fabsf(y1[r])))); }
            float G[4], Gp[4];
#pragma unroll
            for (int uu = 0; uu < 2; ++uu) { float a = 0.f, c = 0.f;
#pragma unroll
                for (int j = 0; j < 8; ++j) { a += L0[8 * uu + j]; c += L1[8 * uu + j]; }
                G[uu] = a; G[2 + uu] = c; }
#pragma unroll
            for (int g = 0; g < 4; ++g) Gp[g] = swap_other(G[g], hi);
            float T[4];
#pragma unroll
            for (int g = 0; g < 4; ++g) T[g] = G[g] + Gp[g];
            float base[4]; { float aft = R;
#pragma unroll
                for (int g = 3; g >= 0; --g) { base[g] = aft + (hi == 0 ? Gp[g] : 0.f); aft += T[g]; }
                R = aft; }
#pragma unroll
            for (int uu = 0; uu < 2; ++uu) { float a0 = base[uu], a1 = base[2 + uu];
#pragma unroll
                for (int j = 7; j >= 0; --j) { const int r = 8 * uu + j; const float l0 = L0[r], l1 = L1[r];
                    y0[r] = __builtin_amdgcn_exp2f(y0[r] + l0 + a0); a0 += l0; y1[r] = __builtin_amdgcn_exp2f(y1[r] + l1 + a1); a1 += l1; } }
            bf16x8 pa[4];
#pragma unroll
            for (int uu = 0; uu < 2; ++uu) { u32x4 a, c; a.x = cvtpk(y0[8 * uu], y0[8 * uu + 1]); a.y = cvtpk(y0[8 * uu + 2], y0[8 * uu + 3]); a.z = cvtpk(y0[8 * uu + 4], y0[8 * uu + 5]); a.w = cvtpk(y0[8 * uu + 6], y0[8 * uu + 7]);
                c.x = cvtpk(y1[8 * uu], y1[8 * uu + 1]); c.y = cvtpk(y1[8 * uu + 2], y1[8 * uu + 3]); c.z = cvtpk(y1[8 * uu + 4], y1[8 * uu + 5]); c.w = cvtpk(y1[8 * uu + 6], y1[8 * uu + 7]);
                pa[uu] = __builtin_bit_cast(bf16x8, a); pa[2 + uu] = __builtin_bit_cast(bf16x8, c); }
            const ALAS unsigned char* Vl = lds + OFF_V + buf * VBUF + r32 * VP + hi * 16;
#pragma unroll
            for (int i = 0; i < 2; ++i)
#pragma unroll
                for (int g = 0; g < 4; ++g) { const bf16x8 vb = *(const ALAS bf16x8*)(Vl + i * 32 * VP + g * 32); o[i] = MFMA32(pa[g], vb, o[i]); }
            wdone = __all(R < -150.f);
        }
        if (more) { const int nb = buf ^ 1; *(ALAS u32x4*)(lds + OFF_K + nb * KBUF + kst) = kr; *(ALAS u32x4*)(lds + OFF_V + nb * VBUF + vst) = v0; }
        const int alld = __syncthreads_and(wdone ? 1 : 0);
        if (!more || alld) break;
    }
    ALAS bf16_t* stg = (ALAS bf16_t*)(lds + OFF_OST) + w * 4096;
#pragma unroll
    for (int r = 0; r < 16; ++r) { const int row = (r & 3) + 8 * (r >> 2) + 4 * hi;
#pragma unroll
        for (int i = 0; i < 2; ++i) stg[row * 64 + 32 * i + r32] = (bf16_t)(cvtpk(o[i][r], 0.f) & 0xffffu); }
    const ALAS bf16_t* sp = stg + (lane >> 3) * 64 + (lane & 7) * 8;
    bf16_t* gp = O + (rowbase + q0 + 32 * w + (lane >> 3)) * LDQ + h * 64 + (lane & 7) * 8;
#pragma unroll 1
    for (int it = 0; it < 4; ++it) { const u32x4 v = *(const ALAS u32x4*)sp; *(u32x4*)gp = v; sp += 8 * 64; gp += 8 * LDQ; }
}
#undef MFMA32
}

#define LAS __attribute__((address_space(3)))
typedef unsigned short bf16;
typedef unsigned v4u __attribute__((ext_vector_type(4)));
typedef float f32x4 __attribute__((ext_vector_type(4)));
constexpr int NWAVES = 8;
constexpr int BATCH = 4, SEQ = 4096, D = 1024, M = BATCH * SEQ, FF = 2816;
constexpr float EPS = 1e-6f;
constexpr float C2 = 0.125f * 1.4426950408889634f;
constexpr size_t MiB = 1u << 20;
constexpr size_t WS_ROPE = 1 * MiB;
constexpr size_t WS_WQK0 = 2 * MiB, WS_WV0 = 6 * MiB, WS_WO0 = 8 * MiB, WS_WGU0 = 10 * MiB, WS_WD0 = 21 * MiB;
constexpr size_t WS_WQK1 = 27 * MiB, WS_WV1 = 31 * MiB, WS_WO1 = 33 * MiB, WS_WGU1 = 35 * MiB, WS_WD1 = 46 * MiB;
constexpr size_t WS_XN = 54 * MiB, WS_QK = 86 * MiB, WS_VT = 150 * MiB, WS_H = 86 * MiB, WS_MF = 182 * MiB, WS_END = 246 * MiB;
constexpr int LDS_BYTES = 147456;

__device__ __forceinline__ unsigned f2bf(float f) { unsigned u = __builtin_bit_cast(unsigned, f); return (u + 0x7fffu + ((u >> 16) & 1u)) >> 16; }
__device__ __forceinline__ unsigned pk2(float lo, float hi) { return f2bf(lo) | (f2bf(hi) << 16); }
__device__ __forceinline__ float wave_sum(float v) {
#pragma unroll
    for (int o = 1; o < 64; o <<= 1) v += __shfl_xor(v, o);
    return v;
}
#ifdef PROBE_SYNC2
#define GSYNC() do { xcd_barrier(mk_bar(lds)); xcd_barrier(mk_bar(lds)); } while (0)
#else
#define GSYNC() xcd_barrier(mk_bar(lds))
#endif
struct Args { const float* in[18]; float* out; unsigned char* ws; };
typedef const __attribute__((address_space(4))) Args* KArgs;
__device__ __forceinline__ KArgs get_args() { auto p = __builtin_amdgcn_kernarg_segment_ptr(); asm volatile("" : "+s"(p)); return (KArgs)p; }

#define XB_TMO      128
#define XB_XCNT(j)  (256  + 64 * (j))
#define XB_XSUB(j)  (1280 + 64 * (j))
#define XB_XGEN(j)  (2304 + 64 * (j))
#define XB_TOP      3328
#define XB_TOPGEN   3392
#define XCD_BAR_WORDS 3456
#define XB_SPIN_CAP (1u << 18)

__device__ __forceinline__ unsigned xb_ld(unsigned* p)              { return __hip_atomic_load(p, __ATOMIC_RELAXED, __HIP_MEMORY_SCOPE_AGENT); }
__device__ __forceinline__ unsigned xb_add(unsigned* p, unsigned v) { return __hip_atomic_fetch_add(p, v, __ATOMIC_RELAXED, __HIP_MEMORY_SCOPE_AGENT); }
__device__ __forceinline__ unsigned xb_xcc_id() { return (unsigned)__builtin_amdgcn_s_getreg((3 << 11) | 20) & 0xFu; }
#define XB_SPIN(cond, bar) do { unsigned _sp = 0; while (cond) { __builtin_amdgcn_s_sleep(1); \
    if ((++_sp & 255u) == 0u) { if (xb_ld(&(bar)[XB_TMO])) break; if (_sp > XB_SPIN_CAP) { atomicAdd(&(bar)[XB_TMO], 1u); break; } } } } while (0)

struct XcdBarrier {
    unsigned* bar; unsigned x;
    volatile LAS unsigned* st;
};

__device__ __forceinline__ XcdBarrier xcd_barrier_post(unsigned* bar, volatile LAS unsigned* st) {
    XcdBarrier b; b.bar = bar; b.x = xb_xcc_id(); b.st = st;
    if (threadIdx.x == 0) (void)xb_add(&bar[XB_XCNT(b.x)], 1u);
    return b;
}
__device__ __forceinline__ void xcd_barrier_complete(unsigned* bar, unsigned x, unsigned& nloc, unsigned& nx) {
    const unsigned G = gridDim.x * gridDim.y * gridDim.z;
    unsigned sum, cnt, mine, sp = 0u;
    for (;;) {
        sum = 0u; cnt = 0u; mine = 0u;
#pragma unroll
        for (unsigned j = 0; j < 16; ++j) { const unsigned c = xb_ld(&bar[XB_XCNT(j)]); sum += c; cnt += (c > 0u) ? 1u : 0u; mine = (j == x) ? c : mine; }
        if (sum == G) break;
        __builtin_amdgcn_s_sleep(1);
        if ((++sp & 255u) == 0u) { if (xb_ld(&bar[XB_TMO])) break; if (sp > XB_SPIN_CAP) { atomicAdd(&bar[XB_TMO], 1u); break; } }
    }
    nloc = mine > 0u ? mine : 1u; nx = cnt > 0u ? cnt : 1u;
}

__device__ __forceinline__ void xcd_barrier(const XcdBarrier& b) {
    asm volatile("s_waitcnt vmcnt(0)" ::: "memory");
    __syncthreads();
    if (threadIdx.x == 0) {
        unsigned* bar = b.bar;
        __builtin_amdgcn_s_waitcnt(0);
        unsigned nloc = b.st[0], nx = b.st[1];
        if (nloc == 0u) { xcd_barrier_complete(bar, b.x, nloc, nx); b.st[0] = nloc; b.st[1] = nx; }
        const unsigned old = xb_add(&bar[XB_XSUB(b.x)], 1u);
        const unsigned gen = old / nloc;
        if (old + 1u == (gen + 1u) * nloc) {
            __builtin_amdgcn_fence(__ATOMIC_RELEASE, "agent");
            asm volatile("s_waitcnt vmcnt(0)" ::: "memory");
            const unsigned og = xb_add(&bar[XB_TOP], 1u);
            const unsigned tg = og / nx;
            if (og + 1u == (tg + 1u) * nx) xb_add(&bar[XB_TOPGEN], 1u);
            else XB_SPIN(xb_ld(&bar[XB_TOPGEN]) == tg, bar);
            __builtin_amdgcn_fence(__ATOMIC_ACQUIRE, "agent");
            xb_add(&bar[XB_XGEN(b.x)], 1u);
            asm volatile("s_waitcnt vmcnt(0)" ::: "memory");
        } else {
            XB_SPIN(xb_ld(&bar[XB_XGEN(b.x)]) == gen, bar);
            __builtin_amdgcn_fence(__ATOMIC_ACQUIRE, "agent");
            asm volatile("s_waitcnt vmcnt(0)" ::: "memory");
        }
    }
    __syncthreads();
}

constexpr size_t WS_CTL = 0, CTL_ZERO_BYTES = 65536;
constexpr int CW_BAR = 4096;
constexpr int MISC_OFF = 131072 + 320;
__device__ __forceinline__ XcdBarrier mk_bar(LAS unsigned char* lds) { XcdBarrier b; b.bar = (unsigned*)(get_args()->ws + WS_CTL) + CW_BAR; b.x = xb_xcc_id(); b.st = (volatile LAS unsigned*)(lds + MISC_OFF) + 8; return b; }
__device__ __forceinline__ void tr_item(const float* W, int ldw, int scol0, int k0, const float* g, float scale, bf16* WT, int K, int drow0, LAS float* scr, int lane) {
#pragma unroll 8
    for (int i = 0; i < 32; ++i) { const int kk = 2 * i + (lane >> 5); const float gg = g ? g[k0 + kk] * scale : scale; scr[kk * 33 + (lane & 31)] = W[(size_t)(k0 + kk) * ldw + scol0 + (lane & 31)] * gg; }
    asm volatile("s_waitcnt lgkmcnt(0)" ::: "memory");
    const int c = lane & 7;
#pragma unroll
    for (int j = 0; j < 4; ++j) { const int n = (lane >> 3) + 8 * j; const LAS float* s = scr + (8 * c) * 33 + n;
        v4u o; o.x = pk2(s[0 * 33], s[1 * 33]); o.y = pk2(s[2 * 33], s[3 * 33]); o.z = pk2(s[4 * 33], s[5 * 33]); o.w = pk2(s[6 * 33], s[7 * 33]);
        *(v4u*)(WT + (size_t)(drow0 + n) * K + k0 + 8 * c) = o; }
    asm volatile("s_waitcnt lgkmcnt(0)" ::: "memory");
}
struct Seg { const float* W; const float* g; bf16* dst; int ldw, K, nout, mode, scol; float scale; };
__device__ __forceinline__ Seg make_seg(KArgs ka, int s) {
    unsigned char* ws = ka->ws; Seg r;
    const float* gpre0 = ka->in[12]; const float* gpre1 = ka->in[12] + D; const float* gf0 = ka->in[14]; const float* gf1 = ka->in[14] + D;
    switch (s) {
    case 0:  r = Seg{ka->in[1], gpre0, (bf16*)(ws + WS_WQK0), 3072, D, 1024, 0, 0, C2}; break;
    case 1:  r = Seg{ka->in[1], gpre0, (bf16*)(ws + WS_WQK0) + (size_t)1024 * D, 3072, D, 1024, 0, 1024, 1.f}; break;
    case 2:  r = Seg{ka->in[1], gpre0, (bf16*)(ws + WS_WV0), 3072, D, 1024, 0, 2048, 1.f}; break;
    case 3:  r = Seg{ka->in[2], nullptr, (bf16*)(ws + WS_WO0), 1024, D, 1024, 0, 0, 1.f}; break;
    case 4:  r = Seg{ka->in[16], gf0, (bf16*)(ws + WS_WGU0), 2 * FF, D, 2 * FF, 1, 0, 1.f}; break;
    case 5:  r = Seg{ka->in[17], nullptr, (bf16*)(ws + WS_WD0), 1024, FF, 1024, 0, 0, 1.f}; break;
    case 6:  r = Seg{ka->in[10], gpre1, (bf16*)(ws + WS_WQK1), 1024, D, 1024, 0, 0, C2}; break;
    case 7:  r = Seg{ka->in[9], ka->in[8], (bf16*)(ws + WS_WQK1) + (size_t)1024 * D, 2048, D, 1024, 0, 0, 1.f}; break;
    case 8:  r = Seg{ka->in[9], ka->in[8], (bf16*)(ws + WS_WV1), 2048, D, 1024, 0, 1024, 1.f}; break;
    case 9:  r = Seg{ka->in[11], nullptr, (bf16*)(ws + WS_WO1), 1024, D, 1024, 0, 0, 1.f}; break;
    case 10: r = Seg{ka->in[16] + (size_t)D * 2 * FF, gf1, (bf16*)(ws + WS_WGU1), 2 * FF, D, 2 * FF, 1, 0, 1.f}; break;
    default: r = Seg{ka->in[17] + (size_t)FF * D, nullptr, (bf16*)(ws + WS_WD1), 1024, FF, 1024, 0, 0, 1.f}; break;
    }
    return r;
}
constexpr int NSEG = 12;

template <int MODE  >
__device__ __forceinline__ void row_phase(const float* xin, const float* mf, const float* g, float* out, bf16* XN, int gw, int NGW, int lane_) {
    int lane = lane_; asm volatile("" : "+v"(lane));
    for (int m = gw; m < M; m += NGW) {
        const f32x4* xr = (const f32x4*)(xin + (size_t)m * D) + lane;
        f32x4 x[4];
#pragma unroll
        for (int j = 0; j < 4; ++j) x[j] = xr[64 * j];
        if (MODE != 0) {
            const f32x4* mr = (const f32x4*)(mf + (size_t)m * D) + lane; const f32x4* gr = (const f32x4*)g + lane;
            f32x4 v[4]; float s = 0.f;
#pragma unroll
            for (int j = 0; j < 4; ++j) { v[j] = mr[64 * j]; s += (v[j].x * v[j].x + v[j].y * v[j].y) + (v[j].z * v[j].z + v[j].w * v[j].w); }
            const float rstd = 1.f / sqrtf(wave_sum(s) * (1.f / D) + EPS);
            f32x4* orow = (f32x4*)(out + (size_t)m * D) + lane;
#pragma unroll
            for (int j = 0; j < 4; ++j) { x[j] = x[j] + v[j] * rstd * gr[64 * j]; orow[64 * j] = x[j]; }
        }
        if (MODE != 2) {
            float s2 = 0.f;
#pragma unroll
            for (int j = 0; j < 4; ++j) s2 += (x[j].x * x[j].x + x[j].y * x[j].y) + (x[j].z * x[j].z + x[j].w * x[j].w);
            const float r2 = 1.f / sqrtf(wave_sum(s2) * (1.f / D) + EPS);
            unsigned long long* o8 = (unsigned long long*)(XN + (size_t)m * D) + lane;
#pragma unroll
            for (int j = 0; j < 4; ++j) o8[64 * j] = (unsigned long long)pk2(x[j].x * r2, x[j].y * r2) | ((unsigned long long)pk2(x[j].z * r2, x[j].w * r2) << 32);
        }
    }
}


template <int layer>
__device__ __forceinline__ void layer_body(LAS unsigned char* lds, cg::grid_group& grid, int G, int bx, int vcu, int gw, int NGW, int lane) {
#define WSB (get_args()->ws)
#define XN ((bf16*)(WSB + WS_XN))
#define QK ((bf16*)(WSB + WS_QK))
#define VT ((bf16*)(WSB + WS_VT))
#define HB ((bf16*)(WSB + WS_H))
#define MF ((float*)(WSB + WS_MF))
#define Wqk ((const bf16*)(WSB + (layer ? WS_WQK1 : WS_WQK0)))
#define Wv ((const bf16*)(WSB + (layer ? WS_WV1 : WS_WV0)))
#define Wo ((const bf16*)(WSB + (layer ? WS_WO1 : WS_WO0)))
#define Wgu ((const bf16*)(WSB + (layer ? WS_WGU1 : WS_WGU0)))
#define Wd ((const bf16*)(WSB + (layer ? WS_WD1 : WS_WD0)))
    {
        pg8::Gemm g{XN, Wqk, M, 2048, D, D, D}; pg8::StaticOrder S; S.init(M, 2048, G, bx);
#ifndef NO_G1
        pg8::EpiBf16<layer == 0> E{QK, 2048, (const float*)(WSB + WS_ROPE)}; pg8::gemm_phase<pg8::EpiBf16<layer == 0>, pg8::StaticOrder, true, true>(lds, g, S, E);
#endif
#ifndef NO_GV
        pg8::Gemm g2{Wv, XN, 1024, M, D, D, D}; pg8::StaticOrder S2; S2.init(1024, M, G, bx);
        pg8::EpiBf16<false> E2{VT, M, nullptr}; pg8::gemm_phase<pg8::EpiBf16<false>, pg8::StaticOrder, true, true>(lds, g2, S2, E2);
#endif
    }
    GSYNC();
    if (layer == 0) {
        KArgs ka = get_args();
        float d1 = wave_sum(ka->in[3][lane] * ka->in[4][lane]), d2 = wave_sum(ka->in[5][lane] * ka->in[6][lane]);
        const float lam = expf(d1) - expf(d2) + 0.2f;
#ifndef NO_DIFF
#ifdef PROBE_DIFF2
        for (int p = vcu; p < 256; p += G) { const int bh = p >> 3, s = p & 7;
            att::diff_unit(lds, QK, VT, (bf16*)MF, bh >> 3, bh & 7, s, lam, get_args()->in[7], 0.8f);
            att::diff_unit(lds, QK, VT, (bf16*)MF, bh >> 3, bh & 7, 15 - s, lam, get_args()->in[7], 0.8f); }
#endif
        for (int p = vcu; p < 256; p += G) { const int bh = p >> 3, s = p & 7;
            att::diff_unit(lds, QK, VT, QK, bh >> 3, bh & 7, s, lam, get_args()->in[7], 0.8f);
            att::diff_unit(lds, QK, VT, QK, bh >> 3, bh & 7, 15 - s, lam, get_args()->in[7], 0.8f); }
#endif
    } else {
#ifndef NO_SB
#ifdef PROBE_SB2
        for (int p = vcu; p < 1024; p += G) { const int bh = p >> 4; att::sb_unit(lds, QK, VT, (bf16*)MF, bh >> 4, bh & 15, p & 15); }
#endif
        for (int p = vcu; p < 1024; p += G) { const int bh = p >> 4; att::sb_unit(lds, QK, VT, QK, bh >> 4, bh & 15, p & 15); }
#endif
    }
    GSYNC();
#ifndef NO_GO
    { pg8::Gemm g{QK, Wo, M, D, D, 2048, D}; pg8::StaticOrder S; S.init(M, D, G, bx); pg8::EpiF32 E{MF, D}; pg8::gemm_phase<pg8::EpiF32, pg8::StaticOrder, true, true>(lds, g, S, E); }
#endif
    GSYNC();
    { KArgs ka = get_args(); row_phase<1>(layer ? ka->out : ka->in[0], MF, ka->in[13] + layer * D, ka->out, XN, gw, NGW, lane); }
    GSYNC();
#ifndef NO_GU
    { pg8::Gemm g{XN, Wgu, M, 2 * FF, D, D, D}; pg8::StaticOrder S; S.init(M, 2 * FF, G, bx); pg8::EpiSwiglu E{HB, FF}; pg8::gemm_phase<pg8::EpiSwiglu, pg8::StaticOrder, true, true>(lds, g, S, E); }
#endif
    GSYNC();
#ifndef NO_GD
    { pg8::Gemm g{HB, Wd, M, D, FF, FF, FF}; pg8::StaticOrder S; S.init(M, D, G, bx); pg8::EpiF32 E{MF, D}; pg8::gemm_phase<pg8::EpiF32, pg8::StaticOrder, true, true>(lds, g, S, E); }
#endif
    GSYNC();
    { KArgs ka = get_args(); if (layer == 0) row_phase<1>(ka->out, MF, ka->in[15], ka->out, XN, gw, NGW, lane);
      else row_phase<2>(ka->out, MF, ka->in[15] + D, ka->out, XN, gw, NGW, lane); }
    if (layer == 0) GSYNC();
#undef XN
#undef QK
#undef VT
#undef HB
#undef MF
#undef Wqk
#undef Wv
#undef Wo
#undef Wgu
#undef Wd
#undef WSB
}

__global__ void __launch_bounds__(NWAVES * 64, 2) fwd_mega(Args a) {
    extern __shared__ __attribute__((aligned(16))) unsigned char lds_raw[];
    cg::grid_group grid = cg::this_grid();
    LAS unsigned char* lds = (LAS unsigned char*)lds_raw;
    const int tid = threadIdx.x, lane = tid & 63, wave = __builtin_amdgcn_readfirstlane(tid >> 6);
    const int G = gridDim.x, bx = blockIdx.x;
    for (int u = tid; u < (LDS_BYTES - 131072) / 4; u += NWAVES * 64) ((LAS unsigned*)(lds + 131072))[u] = 0u;
    __syncthreads();
    (void)xcd_barrier_post((unsigned*)(get_args()->ws + WS_CTL) + CW_BAR, (volatile LAS unsigned*)(lds + MISC_OFF) + 8);
    const int vcu = (G % 8 == 0) ? (bx % 8) * (G / 8) + bx / 8 : bx;
    const int gw = vcu * NWAVES + wave, NGW = G * NWAVES;

    {
        KArgs ka = get_args(); unsigned char* ws = ka->ws; bf16* XN = (bf16*)(ws + WS_XN); float* rope = (float*)(ws + WS_ROPE); const float* x = ka->in[0];
        LAS float* scr = (LAS float*)(lds + wave * 16384);
        int total = 0;
        for (int s = 0; s < NSEG; ++s) { const Seg sg = make_seg(ka, s); total += (sg.K / 64) * (sg.nout / 32); }
        for (int it0 = gw; it0 < total; it0 += NGW) {
            int it = it0;
            for (int s = 0; s < NSEG; ++s) { const Seg sg = make_seg(ka, s); const int nblk = sg.nout / 32, n_it = (sg.K / 64) * nblk;
                if (it < n_it) { const int kb = it / nblk, nb = it % nblk, d0 = 32 * nb;
                    int scol = sg.scol + d0;
                    if (sg.mode == 1) { const int pn = d0 >> 8, bj = (d0 >> 7) & 1, jj = d0 & 127; scol = bj * FF + 128 * pn + jj; }
                    const float sc = sg.scale;
                    tr_item(sg.W, sg.ldw, scol, 64 * kb, sg.g, sc, sg.dst, sg.K, d0, scr, lane); break; }
                it -= n_it; }
        }
        const float invf[8] = {1.0f, 0.1939227432012558f, 0.03760603070259094f, 0.007292664609849453f, 0.0014142135623842478f, 0.00027424818836152554f, 5.3182957344688475e-05f, 1.0313385246263351e-05f};
        for (int idx = bx * (NWAVES * 64) + tid; idx < SEQ * 8; idx += G * NWAVES * 64) {
            const int pos = idx >> 3, i = idx & 7;
            float fr = 1.0f;
#pragma unroll
            for (int k = 0; k < 8; ++k) if (i == k) fr = invf[k];
            const float angf = (float)pos * fr; const double ang = (double)angf;
            const double kq = __builtin_rint(ang * 0.63661977236758134308); const long kk = (long)kq;
            const double r = (ang - kq * 1.57079632679489655800) - kq * 6.12323399573676603587e-17;
            const double r2 = r * r;
            const double sn = r * (1.0 + r2 * (-1.0 / 6 + r2 * (1.0 / 120 + r2 * (-1.0 / 5040 + r2 * (1.0 / 362880 + r2 * (-1.0 / 39916800 + r2 * (1.0 / 6227020800.0)))))));
            const double cs = 1.0 + r2 * (-0.5 + r2 * (1.0 / 24 + r2 * (-1.0 / 720 + r2 * (1.0 / 40320 + r2 * (-1.0 / 3628800 + r2 * (1.0 / 479001600.0))))));
            const int qd = (int)(kk & 3);
            const double c = (qd == 0) ? cs : (qd == 1) ? -sn : (qd == 2) ? -cs : sn;
            const double s = (qd == 0) ? sn : (qd == 1) ? cs : (qd == 2) ? -sn : -cs;
            rope[pos * 16 + i] = (float)c; rope[pos * 16 + 8 + i] = (float)s;
        }
        row_phase<0>(x, nullptr, nullptr, nullptr, XN, gw, NGW, lane);
    }
    grid.sync();

    layer_body<0>(lds, grid, G, bx, vcu, gw, NGW, lane);
    layer_body<1>(lds, grid, G, bx, vcu, gw, NGW, lane);
}

extern "C" void kernel_launch(void* const* d_in, const int* in_sizes, int n_in, void* d_out, int out_size, void* d_ws, size_t ws_size, hipStream_t stream) {
    static int grid = 0;
    if (grid == 0) {
        if (n_in != 18 || in_sizes[0] != M * D || out_size != M * D || ws_size < WS_END) { fprintf(stderr, "kernel_launch: unexpected shapes (n_in %d, in0 %d, out %d, ws %zu)\n", n_in, n_in > 0 ? in_sizes[0] : -1, out_size, ws_size); grid = -1; return; }
        int dev = 0, cus = 0, per_cu = 0;
        hipGetDevice(&dev); hipDeviceGetAttribute(&cus, hipDeviceAttributeMultiprocessorCount, dev);
        if (hipFuncSetAttribute((const void*)fwd_mega, hipFuncAttributeMaxDynamicSharedMemorySize, LDS_BYTES) != hipSuccess) { fprintf(stderr, "kernel_launch: hipFuncSetAttribute failed\n"); grid = -1; return; }
        if (hipOccupancyMaxActiveBlocksPerMultiprocessor(&per_cu, (const void*)fwd_mega, NWAVES * 64, LDS_BYTES) != hipSuccess || per_cu < 1) { fprintf(stderr, "kernel_launch: occupancy query says %d\n", per_cu); per_cu = 1; }
        (void)hipGetLastError();
        grid = cus * 1;
    }
    if (grid < 0) return;
    if (hipMemsetAsync((char*)d_ws + WS_CTL, 0, CTL_ZERO_BYTES, stream) != hipSuccess) { fprintf(stderr, "kernel_launch: hipMemsetAsync failed\n"); return; }
    Args a{};
    for (int i = 0; i < 18; ++i) a.in[i] = (const float*)d_in[i];
    a.out = (float*)d_out; a.ws = (unsigned char*)d_ws;
    void* args[] = {&a};
    hipError_t e = hipLaunchCooperativeKernel((const void*)fwd_mega, dim3(grid), dim3(NWAVES * 64), args, LDS_BYTES, stream);
    if (e != hipSuccess) fprintf(stderr, "kernel_launch: cooperative launch failed: %s (grid %d)\n", hipGetErrorString(e), grid);
}
```
